# Optimizing an MI355X kernel written in HIP

```python
import math
import jax
import jax.numpy as jnp
from jax import lax
import numpy as np

D_MODEL = 1024
BATCH = 8
SEQ = 4096
DEPTH = 1

N_HEADS = 8
HEAD_DIM = 64
N_KV = 2
HPG = N_HEADS // N_KV
CMP_STRIDE = 16
CMP_BLOCK = 2 * CMP_STRIDE
CMP_HIDDEN = 128
SLC_BLOCK = 64
N_SEL = 16
WINDOW = 512
Q_BLOCK = 128
REL_BUCKETS = 32
REL_MAX_DIST = 128
S5_WIDTH = 512
S5_GROUP = 16
S5_GROUPS = S5_WIDTH // S5_GROUP
S5_STATE = 64
S5_DT_MIN = 1e-3
S5_DT_MAX = 1e-1
N_EGROUPS = 8
EXPERTS_PER_GROUP = 8
N_EXPERTS = N_EGROUPS * EXPERTS_PER_GROUP
TOP_K_IN_GROUP = 2
D_EXPERT = 256
EXPERT_BLOCK = 128
DN_ALPHA = (2.0 * DEPTH) ** 0.25
DN_BETA = (8.0 * DEPTH) ** -0.25
LN_EPS = 1e-5
NEG_INF = -1e30
BIG = 1e9

ATTN_WIDTH = N_HEADS * HEAD_DIM
KV_WIDTH = N_KV * HEAD_DIM
KV_OFF = ATTN_WIDTH
NSA_GATE_OFF = KV_OFF + 6 * KV_WIDTH
S5_OFF = NSA_GATE_OFF + 3 * N_HEADS
MERGE_OFF = S5_OFF + S5_WIDTH
D_IN = MERGE_OFF + 2 * D_MODEL

kernel_name = 'hybrid_nsa_s5_hmoe_deepnorm'


def layer_norm(x, g, b):
    xf = x.astype(jnp.float32)
    mu = jnp.mean(xf, -1, keepdims=True)
    var = jnp.mean(jnp.square(xf - mu), -1, keepdims=True)
    return ((xf - mu) * lax.rsqrt(var + LN_EPS) * g.astype(jnp.float32) + b.astype(jnp.float32)).astype(x.dtype)


def t5_bucket(dist):
    n = jnp.maximum(dist, 0)
    max_exact = REL_BUCKETS // 2
    nf = jnp.maximum(n, 1).astype(jnp.float32)
    large = max_exact + (jnp.log(nf / max_exact) / math.log(REL_MAX_DIST / max_exact)
                         * (REL_BUCKETS - max_exact)).astype(jnp.int32)
    large = jnp.minimum(large, REL_BUCKETS - 1)
    return jnp.where(n < max_exact, n, large)


def masked_softmax(s, mask):
    p = jax.nn.softmax(jnp.where(mask, s, NEG_INF), axis=-1)
    return jnp.where(mask, p, 0.0)


def nsa_attention(q, kv, gates, rel_bias, cmp_pos, cmp_w1, cmp_b1, cmp_w2, cmp_b2):
    B, L = q.shape[:2]
    f32 = jnp.float32
    scale = HEAD_DIM ** -0.5
    qg = q.reshape(B, L, N_KV, HPG, HEAD_DIM).transpose(0, 2, 3, 1, 4)
    pos = jnp.arange(L)
    tbl = rel_bias.astype(f32)

    n_cmp = L // CMP_STRIDE - 1

    def compress(t, i):
        c = t.reshape(B, L // CMP_STRIDE, CMP_STRIDE, N_KV, HEAD_DIM)
        blk = jnp.concatenate([c[:, :-1], c[:, 1:]], axis=2)
        blk = blk + cmp_pos[i][None, None, :, None, :]
        blk = blk.transpose(0, 3, 1, 2, 4).reshape(B, N_KV, n_cmp, CMP_BLOCK * HEAD_DIM)
        hid = jax.nn.gelu(blk @ cmp_w1[i] + cmp_b1[i])
        return hid @ cmp_w2[i] + cmp_b2[i]

    kc = compress(kv[:, :, 0], 0)
    vc = compress(kv[:, :, 1], 1)
    cmp_start = jnp.arange(n_cmp) * CMP_STRIDE
    dist_c = pos[:, None] - (cmp_start + CMP_BLOCK - 1)[None, :]
    bias_c = tbl[t5_bucket(dist_c)].transpose(2, 0, 1).reshape(N_KV, HPG, L, n_cmp)
    s_c = jnp.einsum('bghqd,bgkd->bghqk', qg, kc).astype(f32) * scale + bias_c
    p_c = masked_softmax(s_c, dist_c >= 0)
    o_cmp = jnp.einsum('bghqk,bgkd->bghqd', p_c.astype(vc.dtype), vc)

    n_blk = L // SLC_BLOCK
    blk_ids = jnp.arange(n_blk)
    blk_start = blk_ids * SLC_BLOCK
    overlap = ((cmp_start[:, None] <= blk_start[None, :] + SLC_BLOCK - 1)
               & (cmp_start[:, None] + CMP_BLOCK - 1 >= blk_start[None, :])).astype(f32)
    imp = jnp.einsum('bghqk,kn->bgqn', p_c, overlap)
    cur = pos // SLC_BLOCK
    forced = (blk_ids[None, :] == 0) | (blk_ids[None, :] == cur[:, None]) | (blk_ids[None, :] == cur[:, None] - 1)
    valid = blk_start[None, :] <= pos[:, None]
    score = jnp.where(forced, BIG, jnp.where(valid, imp, -BIG))
    n_sel = min(N_SEL, n_blk)
    _, sel_idx = lax.top_k(score, n_sel)

    ks = kv[:, :, 2].transpose(0, 2, 1, 3).reshape(B, N_KV, n_blk, SLC_BLOCK, HEAD_DIM)
    vs = kv[:, :, 3].transpose(0, 2, 1, 3).reshape(B, N_KV, n_blk, SLC_BLOCK, HEAD_DIM)
    pad = ((0, 0), (0, 0), (WINDOW, 0), (0, 0))
    kw = jnp.pad(kv[:, :, 4].transpose(0, 2, 1, 3), pad)
    vw = jnp.pad(kv[:, :, 5].transpose(0, 2, 1, 3), pad)
    tbl_g = tbl.reshape(REL_BUCKETS, N_KV, HPG).transpose(1, 0, 2)
    bi = jnp.arange(B)[:, None, None, None]
    gi = jnp.arange(N_KV)[None, :, None, None]

    def query_block(c):
        q0 = c * Q_BLOCK
        qc = lax.dynamic_slice_in_dim(qg, q0, Q_BLOCK, axis=3)
        tq = q0 + jnp.arange(Q_BLOCK)
        idx = lax.dynamic_slice_in_dim(sel_idx, q0, Q_BLOCK, axis=2)
        kg = ks[bi, gi, idx]
        vg = vs[bi, gi, idx]
        kpos = idx[..., None] * SLC_BLOCK + jnp.arange(SLC_BLOCK)
        dist = tq[None, None, :, None, None] - kpos
        bias = tbl_g[gi[..., None], t5_bucket(dist)].transpose(0, 1, 5, 2, 3, 4)
        s = jnp.einsum('bghqd,bgqnsd->bghqns', qc, kg).astype(f32) * scale + bias
        s = s.reshape(B, N_KV, HPG, Q_BLOCK, n_sel * SLC_BLOCK)
        m = (dist >= 0).reshape(B, N_KV, 1, Q_BLOCK, n_sel * SLC_BLOCK)
        p = masked_softmax(s, m)
        o_s = jnp.einsum('bghqm,bgqmd->bghqd', p.astype(vg.dtype),
                         vg.reshape(B, N_KV, Q_BLOCK, n_sel * SLC_BLOCK, HEAD_DIM))
        kwc = lax.dynamic_slice_in_dim(kw, q0, Q_BLOCK + WINDOW, axis=2)
        vwc = lax.dynamic_slice_in_dim(vw, q0, Q_BLOCK + WINDOW, axis=2)
        kpos_w = q0 - WINDOW + jnp.arange(Q_BLOCK + WINDOW)
        dist_w = tq[:, None] - kpos_w[None, :]
        mask_w = (dist_w >= 0) & (dist_w < WINDOW) & (kpos_w[None, :] >= 0)
        bias_w = tbl[t5_bucket(dist_w)].transpose(2, 0, 1).reshape(N_KV, HPG, Q_BLOCK, Q_BLOCK + WINDOW)
        s_w = jnp.einsum('bghqd,bgkd->bghqk', qc, kwc).astype(f32) * scale + bias_w
        p_w = masked_softmax(s_w, mask_w)
        o_w = jnp.einsum('bghqk,bgkd->bghqd', p_w.astype(vwc.dtype), vwc)
        return o_s, o_w

    o_slc, o_win = lax.map(query_block, jnp.arange(L // Q_BLOCK))
    o_slc = o_slc.transpose(1, 0, 4, 2, 3, 5).reshape(B, L, N_HEADS, HEAD_DIM)
    o_win = o_win.transpose(1, 0, 4, 2, 3, 5).reshape(B, L, N_HEADS, HEAD_DIM)
    o_cmp = o_cmp.transpose(0, 3, 1, 2, 4).reshape(B, L, N_HEADS, HEAD_DIM)
    o = gates[..., 0:1] * o_cmp + gates[..., 1:2] * o_slc + gates[..., 2:3] * o_win
    return o.astype(q.dtype).reshape(B, L, ATTN_WIDTH)


def s5_layer(u, lam_re, lam_im, log_dt, b_re, b_im, c_re, c_im, d_skip):
    B, L, _ = u.shape
    f32 = jnp.float32
    uf = u.astype(f32).reshape(B, L, S5_GROUPS, S5_GROUP)
    dt = jnp.exp(log_dt.astype(f32))[:, None]
    lr, li = lam_re.astype(f32), lam_im.astype(f32)
    mag = jnp.exp(lr * dt)
    ab_re, ab_im = mag * jnp.cos(li * dt), mag * jnp.sin(li * dt)
    nr, ni = ab_re - 1.0, ab_im
    den = lr * lr + li * li
    fr, fi = (nr * lr + ni * li) / den, (ni * lr - nr * li) / den
    br, bim = b_re.astype(f32), b_im.astype(f32)
    bb_re = fr[..., None] * br - fi[..., None] * bim
    bb_im = fr[..., None] * bim + fi[..., None] * br
    bu_re = jnp.einsum('blgh,gph->blgp', uf, bb_re)
    bu_im = jnp.einsum('blgh,gph->blgp', uf, bb_im)
    a_re = jnp.broadcast_to(ab_re[None, None], (1, L, S5_GROUPS, S5_STATE))
    a_im = jnp.broadcast_to(ab_im[None, None], (1, L, S5_GROUPS, S5_STATE))

    def combine(e1, e2):
        a1r, a1i, b1r, b1i = e1
        a2r, a2i, b2r, b2i = e2
        return (a2r * a1r - a2i * a1i, a2r * a1i + a2i * a1r,
                a2r * b1r - a2i * b1i + b2r, a2r * b1i + a2i * b1r + b2i)

    _, _, xr, xi = lax.associative_scan(combine, (a_re, a_im, bu_re, bu_im), axis=1)
    y = (jnp.einsum('blgp,ghp->blgh', xr, c_re.astype(f32))
         - jnp.einsum('blgp,ghp->blgh', xi, c_im.astype(f32))
         + d_skip.astype(f32) * uf)
    return y.reshape(B, L, S5_WIDTH).astype(u.dtype)


def hier_moe(h, w_rg, b_rg, w_re, b_re, w_gate, w_up, w_down):
    B, L, D = h.shape
    N = B * L
    f32 = jnp.float32
    xt = h.reshape(N, D)
    tok_ids = jnp.arange(N)
    g_logits = (xt @ w_rg).astype(f32) + b_rg.astype(f32)
    g_prob = jax.nn.softmax(g_logits, -1)
    g_top = jnp.argmax(g_logits, -1)
    p_group = g_prob[tok_ids, g_top][:, None]
    e_logits = ((xt @ w_re).astype(f32) + b_re.astype(f32)).reshape(N, N_EGROUPS, EXPERTS_PER_GROUP)
    e_logits = e_logits[tok_ids, g_top]
    top_v, top_i = lax.top_k(e_logits, TOP_K_IN_GROUP)
    w = jax.nn.softmax(top_v, -1) * p_group
    expert = g_top[:, None].astype(jnp.int32) * EXPERTS_PER_GROUP + top_i
    A = N * TOP_K_IN_GROUP
    e_flat = expert.reshape(A)
    w_flat = w.reshape(A)
    tok = jnp.repeat(tok_ids, TOP_K_IN_GROUP)
    order = jnp.argsort(e_flat)
    e_s, tok_s, w_s = e_flat[order], tok[order], w_flat[order]
    counts = jnp.bincount(e_flat, length=N_EXPERTS)
    padded = (counts + EXPERT_BLOCK - 1) // EXPERT_BLOCK * EXPERT_BLOCK
    start = jnp.cumsum(counts) - counts
    pend = jnp.cumsum(padded)
    pstart = pend - padded
    dest = pstart[e_s] + (jnp.arange(A) - start[e_s])
    n_blocks = -(-A // EXPERT_BLOCK) + N_EXPERTS
    cap = n_blocks * EXPERT_BLOCK
    row_tok = jnp.full((cap,), N, jnp.int32).at[dest].set(tok_s)
    blk_expert = jnp.minimum(jnp.searchsorted(pend, jnp.arange(n_blocks) * EXPERT_BLOCK, side='right'),
                             N_EXPERTS - 1)
    x_pad = jnp.concatenate([xt, jnp.zeros((1, D), xt.dtype)], axis=0)

    def run_block(args):
        rows, e = args
        xb = x_pad[rows]
        hb = jax.nn.silu(xb @ w_gate[e]) * (xb @ w_up[e])
        return hb @ w_down[e]

    yb = lax.map(run_block, (row_tok.reshape(n_blocks, EXPERT_BLOCK), blk_expert))
    y_assign = yb.reshape(cap, D)[dest].astype(f32) * w_s[:, None]
    out = jax.ops.segment_sum(y_assign, tok_s, num_segments=N)
    return out.astype(h.dtype).reshape(B, L, D)


def setup_inputs(seed: int = 0) -> dict:
    key = jax.random.key(seed)
    ks = jax.random.split(key, 40)
    f32 = jnp.float32

    def nrm(k, shape, s):
        return jax.random.normal(k, shape, f32) * s

    Dp = DEPTH
    col_scale = np.ones((D_IN,), np.float32)
    for j in (1, 3, 5):
        col_scale[KV_OFF + j * KV_WIDTH: KV_OFF + (j + 1) * KV_WIDTH] = DN_BETA
    col_scale = jnp.asarray(col_scale)
    lam_im0 = jnp.broadcast_to(math.pi * jnp.arange(S5_STATE, dtype=f32), (Dp, S5_GROUPS, S5_STATE))
    return {
        'x': nrm(ks[0], (BATCH, SEQ, D_MODEL), 1.0),
        'rel_bias': nrm(ks[1], (REL_BUCKETS, N_HEADS), 0.1),
        'w_in': nrm(ks[2], (Dp, D_MODEL, D_IN), D_MODEL ** -0.5) * col_scale,
        'b_in': nrm(ks[3], (Dp, D_IN), 0.01),
        'cmp_pos': nrm(ks[4], (Dp, 2, CMP_BLOCK, HEAD_DIM), 0.1),
        'cmp_w1': nrm(ks[5], (Dp, 2, CMP_BLOCK * HEAD_DIM, CMP_HIDDEN), (CMP_BLOCK * HEAD_DIM) ** -0.5),
        'cmp_b1': nrm(ks[6], (Dp, 2, CMP_HIDDEN), 0.01),
        'cmp_w2': nrm(ks[7], (Dp, 2, CMP_HIDDEN, HEAD_DIM), CMP_HIDDEN ** -0.5),
        'cmp_b2': nrm(ks[8], (Dp, 2, HEAD_DIM), 0.01),
        'w_attn_up': nrm(ks[9], (Dp, ATTN_WIDTH, D_MODEL), ATTN_WIDTH ** -0.5) * DN_BETA,
        's5_lambda_re': -0.5 + nrm(ks[10], (Dp, S5_GROUPS, S5_STATE), 0.01),
        's5_lambda_im': lam_im0 + nrm(ks[11], (Dp, S5_GROUPS, S5_STATE), 0.01),
        's5_log_dt': jax.random.uniform(ks[12], (Dp, S5_GROUPS), f32, math.log(S5_DT_MIN), math.log(S5_DT_MAX)),
        's5_b_re': nrm(ks[13], (Dp, S5_GROUPS, S5_STATE, S5_GROUP), (2 * S5_GROUP) ** -0.5),
        's5_b_im': nrm(ks[14], (Dp, S5_GROUPS, S5_STATE, S5_GROUP), (2 * S5_GROUP) ** -0.5),
        's5_c_re': nrm(ks[15], (Dp, S5_GROUPS, S5_GROUP, S5_STATE), S5_STATE ** -0.5),
        's5_c_im': nrm(ks[16], (Dp, S5_GROUPS, S5_GROUP, S5_STATE), S5_STATE ** -0.5),
        's5_d': nrm(ks[17], (Dp, S5_GROUPS, S5_GROUP), 1.0),
        's5_w_val': nrm(ks[18], (Dp, S5_WIDTH, D_MODEL), S5_WIDTH ** -0.5) * DN_BETA,
        's5_w_gate': nrm(ks[19], (Dp, S5_WIDTH, D_MODEL), S5_WIDTH ** -0.5),
        's5_b_gate': nrm(ks[20], (Dp, D_MODEL), 0.01),
        'w_out': nrm(ks[21], (Dp, D_MODEL, D_MODEL), D_MODEL ** -0.5) * DN_BETA,
        'ln1_g': 1.0 + nrm(ks[22], (Dp, D_MODEL), 0.01),
        'ln1_b': nrm(ks[23], (Dp, D_MODEL), 0.01),
        'router_w_group': nrm(ks[24], (Dp, D_MODEL, N_EGROUPS), D_MODEL ** -0.5),
        'router_b_group': nrm(ks[25], (Dp, N_EGROUPS), 0.01),
        'router_w_expert': nrm(ks[26], (Dp, D_MODEL, N_EXPERTS), D_MODEL ** -0.5),
        'router_b_expert': nrm(ks[27], (Dp, N_EXPERTS), 0.01),
        'exp_w_gate': nrm(ks[28], (Dp, N_EXPERTS, D_MODEL, D_EXPERT), D_MODEL ** -0.5),
        'exp_w_up': nrm(ks[29], (Dp, N_EXPERTS, D_MODEL, D_EXPERT), D_MODEL ** -0.5) * DN_BETA,
        'exp_w_down': nrm(ks[30], (Dp, N_EXPERTS, D_EXPERT, D_MODEL), D_EXPERT ** -0.5) * DN_BETA,
        'ln2_g': 1.0 + nrm(ks[31], (Dp, D_MODEL), 0.01),
        'ln2_b': nrm(ks[32], (Dp, D_MODEL), 0.01),
    }


def reference(x, rel_bias, w_in, b_in, cmp_pos, cmp_w1, cmp_b1, cmp_w2, cmp_b2, w_attn_up,
              s5_lambda_re, s5_lambda_im, s5_log_dt, s5_b_re, s5_b_im, s5_c_re, s5_c_im, s5_d,
              s5_w_val, s5_w_gate, s5_b_gate, w_out, ln1_g, ln1_b,
              router_w_group, router_b_group, router_w_expert, router_b_expert,
              exp_w_gate, exp_w_up, exp_w_down, ln2_g, ln2_b):
    B, L, D = x.shape
    for l in range(DEPTH):
        proj = x @ w_in[l] + b_in[l]
        q = proj[..., :ATTN_WIDTH].reshape(B, L, N_HEADS, HEAD_DIM)
        kv = proj[..., KV_OFF:NSA_GATE_OFF].reshape(B, L, 6, N_KV, HEAD_DIM)
        nsa_g = jax.nn.sigmoid(proj[..., NSA_GATE_OFF:S5_OFF].astype(jnp.float32)).reshape(B, L, N_HEADS, 3)
        u = proj[..., S5_OFF:MERGE_OFF]
        merge = jax.nn.sigmoid(proj[..., MERGE_OFF:].astype(jnp.float32)).reshape(B, L, 2, D)
        y_a = nsa_attention(q, kv, nsa_g, rel_bias, cmp_pos[l], cmp_w1[l], cmp_b1[l],
                            cmp_w2[l], cmp_b2[l]) @ w_attn_up[l]
        y_s = s5_layer(u, s5_lambda_re[l], s5_lambda_im[l], s5_log_dt[l], s5_b_re[l], s5_b_im[l],
                       s5_c_re[l], s5_c_im[l], s5_d[l])
        z = jax.nn.gelu(y_s)
        y_b = (z @ s5_w_val[l]) * jax.nn.sigmoid(z @ s5_w_gate[l] + s5_b_gate[l])
        mixed = (merge[:, :, 0] * y_a + merge[:, :, 1] * y_b).astype(x.dtype)
        x = layer_norm(DN_ALPHA * x + mixed @ w_out[l], ln1_g[l], ln1_b[l])
        y_m = hier_moe(x, router_w_group[l], router_b_group[l], router_w_expert[l], router_b_expert[l],
                       exp_w_gate[l], exp_w_up[l], exp_w_down[l])
        x = layer_norm(DN_ALPHA * x + y_m, ln2_g[l], ln2_b[l])
    return x
```

```cpp
#include <hip/hip_runtime.h>
#include <cstdio>
#include <cstdint>
#include <cmath>
namespace pg8 {
#define PG8_LAS __attribute__((address_space(3)))
typedef unsigned short bf16_t;
typedef short bf16x8 __attribute__((ext_vector_type(8)));
typedef float f32x4 __attribute__((ext_vector_type(4)));
typedef unsigned u32x4 __attribute__((ext_vector_type(4)));
constexpr int BM = 256, BK = 64, HALF = 128, HTB = HALF * BK * 2  , STAGE_BYTES = 8 * HTB, NXCD = 8, WGM = 8;

__host__ __device__ __forceinline__ int lds_byte(int r, int c) { const int st = (r >> 4) * 2 + (c >> 5), rr = r & 15, cc = c & 31, ob = rr * 64 + cc * 2; return st * 1024 + (ob ^ (((ob >> 9) & 1) << 5)); }
__host__ __device__ __forceinline__ void stage_rc(int b, int& R, int& C) { const int st = b / 1024, sb = b % 1024, swz = sb ^ (((sb >> 9) & 1) << 5); R = (st >> 1) * 16 + swz / 64; C = (st & 1) * 32 + (swz % 64) / 2; }
__host__ __device__ __forceinline__ int perm32(int rho) { const int n = rho >> 4, i = rho & 15; return 8 * (i >> 2) + 4 * n + (i & 3); }

struct Unit { int pm, pn; };
struct Gemm { const bf16_t* A; const bf16_t* Bt; int lda, ldb, K; };

struct StaticOrder {
    int nM, nN, nwg, G, c;
    __host__ __device__ void init(int M, int N, int G_, int c_) { nM = M / BM; nN = N / BM; nwg = nM * nN; G = G_; c = c_; }
    __host__ __device__ bool next(int i, Unit& u) const {
        const long L = (long)i * G + c; if (L >= nwg) return false;
        int wgid = (int)L; { const int q = nwg / NXCD, r = nwg % NXCD, xcd = wgid % NXCD, off = wgid / NXCD; wgid = (xcd < r ? xcd * (q + 1) : r * (q + 1) + (xcd - r) * q) + off; }
        const int nig = WGM * nN, gid = wgid / nig, fm = gid * WGM, gsz = (nM - fm) < WGM ? (nM - fm) : WGM;
        u.pm = fm + ((wgid % nig) % gsz); u.pn = (wgid % nig) / gsz; return true;
    }
    __device__ __forceinline__ void a_ready(const Unit&) const {}
    __device__ __forceinline__ void done(const Unit&) const {}
};

__device__ __forceinline__ unsigned cvt_pk_bf16(float lo, float hi) { unsigned r; asm volatile("v_cvt_pk_bf16_f32 %0, %1, %2" : "=v"(r) : "v"(lo), "v"(hi)); return r; }

template <class Epi, class Sched, bool ALIGN_EPI = false, bool SP2 = false, bool KEEP_ACC = false>
__device__ __forceinline__ void gemm_phase(PG8_LAS unsigned char* lds, const Gemm g, const Sched& S, const Epi& E) {
    const int tid = threadIdx.x, wid = __builtin_amdgcn_readfirstlane(tid >> 6), lane = tid & 63, wr = wid >> 2, wc = wid & 3, fr = lane & 15, fq = lane >> 4;
    const int K = g.K, nt = K / BK;
    unsigned voffA[2], voffB[2];
#pragma unroll
    for (int i = 0; i < 2; ++i) { int R, C; stage_rc(tid * 16 + i * 8192, R, C); const int Rb = Epi::PERM ? ((R & ~31) + perm32(R & 31)) : R;
        voffA[i] = (unsigned)(R * g.lda + C) * 2u; voffB[i] = (unsigned)(Rb * g.ldb + C) * 2u; }
    const size_t kstep = (size_t)(BK * 2);
    const size_t hstepA = (size_t)HALF * g.lda * 2, hstepB = (size_t)HALF * g.ldb * 2;
    const size_t tstepA = 2 * hstepA, tstepB = 2 * hstepB;
    const unsigned ldsw = (unsigned)wid * 1024u;
    const int aoff = lds_byte(wr * 64 + fr, fq * 8), boff = lds_byte(wc * 32 + fr, fq * 8);
#define PG8_SA(b, h) (((b) * 2 + (h)) * HTB)
#define PG8_SB(b, h) ((4 + (b) * 2 + (h)) * HTB)
#define PG8_STAGE(bufoff, gbase, voff) do { _Pragma("unroll") for (int _i = 0; _i < 2; ++_i) \
        __builtin_amdgcn_global_load_lds((const unsigned*)((const char*)(gbase) + (voff)[_i]), (PG8_LAS unsigned*)(lds + (bufoff) + ldsw + _i * 8192), 16, 0, 0); } while (0)
#define PG8_LDA(dst, b, h) do { _Pragma("unroll") for (int m = 0; m < 4; ++m) _Pragma("unroll") for (int k = 0; k < 2; ++k) dst[m][k] = *(const PG8_LAS bf16x8*)(lds + PG8_SA(b, h) + aoff + m * 2048 + k * 1024); } while (0)
#define PG8_LDB(dst, b, h) do { _Pragma("unroll") for (int n = 0; n < 2; ++n) _Pragma("unroll") for (int k = 0; k < 2; ++k) dst[n][k] = *(const PG8_LAS bf16x8*)(lds + PG8_SB(b, h) + boff + n * 2048 + k * 1024); } while (0)
#define PG8_MMA(ai, bj, At, Bt) do { __builtin_amdgcn_s_setprio(1); _Pragma("unroll") for (int m = 0; m < 4; ++m) _Pragma("unroll") for (int n = 0; n < 2; ++n) _Pragma("unroll") for (int k = 0; k < 2; ++k) \
        acc[ai][bj][m][n] = __builtin_amdgcn_mfma_f32_16x16x32_bf16(Bt[n][k], At[m][k], acc[ai][bj][m][n], 0, 0, 0); __builtin_amdgcn_s_setprio(0); } while (0)
#define PG8_WAIT_V(n) asm volatile("s_waitcnt vmcnt(" #n ")" ::: "memory")
#define PG8_WAIT_L(n) asm volatile("s_waitcnt lgkmcnt(" #n ")" ::: "memory")
#define PG8_BAR __builtin_amdgcn_s_barrier()
#define PG8_SCHED __builtin_amdgcn_sched_barrier(0)
    Unit cur, nxt; int ui = 0;
    if (!S.next(0, cur)) return;
    f32x4 acc[2][2][4][2];
#pragma unroll
    for (int a = 0; a < 2; ++a)
#pragma unroll
        for (int b = 0; b < 2; ++b)
#pragma unroll
            for (int m = 0; m < 4; ++m)
#pragma unroll
                for (int n = 0; n < 2; ++n) acc[a][b][m][n] = (f32x4){0.f, 0.f, 0.f, 0.f};
    bf16x8 At[4][2], B0[2][2], B1[2][2];
    const char* cA = (const char*)g.A + (size_t)cur.pm * tstepA; const char* cB = (const char*)g.Bt + (size_t)cur.pn * tstepB;
    S.a_ready(cur);
    if constexpr (SP2) {
        PG8_STAGE(PG8_SB(0, 0), cB, voffB); PG8_STAGE(PG8_SB(0, 1), cB + hstepB, voffB); PG8_STAGE(PG8_SA(0, 0), cA, voffA); PG8_STAGE(PG8_SA(0, 1), cA + hstepA, voffA);
        if (wr == 1) PG8_BAR;
        PG8_WAIT_V(2); PG8_BAR;
        PG8_STAGE(PG8_SB(1, 0), cB + kstep, voffB); PG8_STAGE(PG8_SA(1, 0), cA + kstep, voffA); PG8_STAGE(PG8_SB(1, 1), cB + hstepB + kstep, voffB);
        PG8_WAIT_V(6); PG8_BAR;
    } else {
        PG8_STAGE(PG8_SB(0, 0), cB, voffB); PG8_STAGE(PG8_SA(0, 0), cA, voffA); PG8_STAGE(PG8_SB(0, 1), cB + hstepB, voffB); PG8_STAGE(PG8_SA(0, 1), cA + hstepA, voffA);
        if (wr == 1) PG8_BAR;
        PG8_WAIT_V(4); PG8_BAR;
        PG8_STAGE(PG8_SB(1, 0), cB + kstep, voffB); PG8_STAGE(PG8_SA(1, 0), cA + kstep, voffA); PG8_STAGE(PG8_SB(1, 1), cB + hstepB + kstep, voffB);
        PG8_WAIT_V(6); PG8_BAR;
    }
    for (;;) {
        const bool has_next = S.next(ui + 1, nxt);
        const char* nA = has_next ? (const char*)g.A + (size_t)nxt.pm * tstepA : cA; const char* nB = has_next ? (const char*)g.Bt + (size_t)nxt.pn * tstepB : cB;
        for (int t = 0; t < nt; t += 2) {
            const bool last = (t == nt - 2);
            const char* a1 = cA + (size_t)(t + 1) * kstep;
            const char* a2 = last ? nA : cA + (size_t)(t + 2) * kstep; const char* b2 = last ? nB : cB + (size_t)(t + 2) * kstep;
            const char* a3 = a2 + kstep; const char* b3 = b2 + kstep;
            if (last && has_next) S.a_ready(nxt);
            if constexpr (SP2) {
            PG8_LDB(B0, 0, 0); PG8_LDB(B1, 0, 1); PG8_SCHED; PG8_LDA(At, 0, 0); PG8_STAGE(PG8_SA(1, 1), a1 + hstepA, voffA);
            PG8_WAIT_V(8); PG8_WAIT_L(0); PG8_BAR; PG8_MMA(0, 0, At, B0); PG8_MMA(0, 1, At, B1); PG8_BAR; PG8_SCHED;
            PG8_LDA(At, 0, 1); PG8_STAGE(PG8_SB(0, 0), b2, voffB); PG8_STAGE(PG8_SB(0, 1), b2 + hstepB, voffB); PG8_STAGE(PG8_SA(0, 0), a2, voffA);
            PG8_WAIT_V(8); PG8_WAIT_L(0); PG8_BAR; PG8_MMA(1, 0, At, B0); PG8_MMA(1, 1, At, B1); PG8_BAR; PG8_SCHED;
            PG8_LDB(B0, 1, 0); PG8_LDB(B1, 1, 1); PG8_SCHED; PG8_LDA(At, 1, 0); PG8_STAGE(PG8_SA(0, 1), a2 + hstepA, voffA);
            PG8_WAIT_V(8); PG8_WAIT_L(0); PG8_BAR; PG8_MMA(0, 0, At, B0); PG8_MMA(0, 1, At, B1); PG8_BAR; PG8_SCHED;
            PG8_LDA(At, 1, 1); PG8_STAGE(PG8_SB(1, 0), b3, voffB); PG8_STAGE(PG8_SB(1, 1), b3 + hstepB, voffB); PG8_STAGE(PG8_SA(1, 0), a3, voffA);
            PG8_WAIT_V(8); PG8_WAIT_L(0); PG8_BAR; PG8_MMA(1, 0, At, B0); PG8_MMA(1, 1, At, B1); PG8_BAR; PG8_SCHED;
            } else {
            PG8_LDB(B0, 0, 0); PG8_SCHED; PG8_LDA(At, 0, 0); PG8_STAGE(PG8_SA(1, 1), a1 + hstepA, voffA);
            PG8_WAIT_L(8); PG8_BAR; PG8_WAIT_L(0); PG8_MMA(0, 0, At, B0); PG8_BAR; PG8_SCHED;
            PG8_LDB(B1, 0, 1); PG8_STAGE(PG8_SB(0, 0), b2, voffB);
            PG8_BAR; PG8_WAIT_L(0); PG8_MMA(0, 1, At, B1); PG8_BAR;
            PG8_LDA(At, 0, 1); PG8_STAGE(PG8_SA(0, 0), a2, voffA);
            PG8_BAR; PG8_WAIT_L(0); PG8_MMA(1, 0, At, B0); PG8_BAR; PG8_SCHED;
            PG8_STAGE(PG8_SB(0, 1), b2 + hstepB, voffB);
            PG8_WAIT_V(6); PG8_BAR; PG8_MMA(1, 1, At, B1); PG8_BAR;
            PG8_LDB(B0, 1, 0); PG8_SCHED; PG8_LDA(At, 1, 0); PG8_STAGE(PG8_SA(0, 1), a2 + hstepA, voffA);
            PG8_WAIT_L(8); PG8_BAR; PG8_WAIT_L(0); PG8_MMA(0, 0, At, B0); PG8_BAR; PG8_SCHED;
            PG8_LDB(B1, 1, 1); PG8_STAGE(PG8_SB(1, 0), b3, voffB);
            PG8_BAR; PG8_WAIT_L(0); PG8_MMA(0, 1, At, B1); PG8_BAR;
            PG8_LDA(At, 1, 1); PG8_STAGE(PG8_SA(1, 0), a3, voffA);
            PG8_BAR; PG8_WAIT_L(0); PG8_MMA(1, 0, At, B0); PG8_BAR; PG8_SCHED;
            PG8_STAGE(PG8_SB(1, 1), b3 + hstepB, voffB);
            PG8_WAIT_V(6); PG8_BAR; PG8_MMA(1, 1, At, B1); PG8_BAR;
            }
        }
        if constexpr (ALIGN_EPI) { if (wr == 0) PG8_BAR; }
        if constexpr (!Epi::AFTER_DRAIN) { E(acc, cur, wr, wc, fr, fq); S.done(cur); }
        if (!has_next) break;
        if constexpr (!KEEP_ACC) {
#pragma unroll
        for (int a = 0; a < 2; ++a)
#pragma unroll
            for (int b = 0; b < 2; ++b)
#pragma unroll
                for (int m = 0; m < 4; ++m)
#pragma unroll
                    for (int n = 0; n < 2; ++n) acc[a][b][m][n] = (f32x4){0.f, 0.f, 0.f, 0.f};
        }
        cur = nxt; cA = nA; cB = nB; ++ui;
        if constexpr (ALIGN_EPI) { if (wr == 1) PG8_BAR; }
    }
    PG8_WAIT_V(0);
    if constexpr (!ALIGN_EPI) { if (wr == 0) PG8_BAR; }
    PG8_BAR;
    if constexpr (Epi::AFTER_DRAIN) { E.fused(acc, cur, wr, wc, fr, fq, lds, wid, lane); S.done(cur); }
#undef PG8_SA
#undef PG8_SB
#undef PG8_STAGE
#undef PG8_LDA
#undef PG8_LDB
#undef PG8_MMA
#undef PG8_WAIT_V
#undef PG8_WAIT_L
#undef PG8_BAR
#undef PG8_SCHED
}
}

constexpr int NWAVES = 8;
#ifndef MK_N_LAUNCHES
#define MK_N_LAUNCHES 1
#endif
constexpr int N_PHASES = 13;
constexpr int DM = 1024, NB = 8, SEQ = 4096, NTOK = NB * SEQ;
constexpr int NPROJ = 4096;
constexpr int D_IN = 3864;
constexpr int MOE_CAP = 2 * NTOK + 64 * 256;
constexpr float LN_EPS = 1e-5f;
constexpr float DN_ALPHA = 1.189207115002721f;

constexpr size_t MiB = 1u << 20;
constexpr size_t WS_CTL = 0, CTL_ZERO_BYTES = 64 * 1024;
constexpr size_t WS_SMALL = 1 * MiB;
constexpr size_t WS_WAT = 2 * MiB, WS_WVGT = 3 * MiB, WS_WOT = 5 * MiB, WS_W1CT = 7 * MiB, WS_BPT = 9 * MiB, WS_CT = 13 * MiB;
constexpr size_t WS_ROUTE = 19 * MiB;
constexpr size_t WS_HIST = 1 * MiB + 128 * 1024;
constexpr size_t WS_KC = 20 * MiB;
constexpr size_t WS_HID = 21 * MiB;
constexpr size_t WS_WRT = 25 * MiB;
constexpr size_t WS_WGUT = 26 * MiB, WS_WDT = 90 * MiB;
constexpr size_t WS_MG = 122 * MiB;
constexpr size_t WS_H1 = WS_MG;
constexpr size_t WS_XB = 250 * MiB;
constexpr size_t WS_Z = 250 * MiB, WS_O = 282 * MiB, WS_H1B = 250 * MiB, WS_HB = 250 * MiB;
constexpr size_t WS_Q = 314 * MiB, WS_KV = 346 * MiB, WS_SA = 394 * MiB, WS_G = 442 * MiB, WS_WINT = 444 * MiB, WS_E = 452 * MiB;
constexpr size_t WS_HLO = 314 * MiB;
constexpr size_t WS_T = 314 * MiB;
constexpr size_t WS_MIX = 394 * MiB;
constexpr size_t WS_XS = 314 * MiB, WS_Y2 = 314 * MiB;
constexpr size_t WS_END = 512 * MiB;
static_assert(WS_XS + (size_t)MOE_CAP * 1024 * 2 <= WS_END && WS_HB + (size_t)MOE_CAP * 256 * 2 <= WS_XS, "d_ws map");
constexpr size_t SM_BIASR = 0;
constexpr size_t SM_B1C = 32 * 1024;
constexpr size_t SM_LUT = 40 * 1024;
constexpr size_t SM_A16 = 48 * 1024;
constexpr int CW_CNT = 64, CW_CUR = 128;
constexpr int CW_BAR = 4096;

constexpr int RING_OFF = 0, RING_BYTES = 131072;
constexpr int LDSCTL_OFF = RING_BYTES, MISC_OFF = LDSCTL_OFF + 320;
constexpr int LTAB_OFF = LDSCTL_OFF + 1024;
constexpr int LDS_BYTES = 147456;

#define GAS __attribute__((address_space(1)))
#define LAS __attribute__((address_space(3)))
typedef unsigned short bf16;
typedef unsigned v4u __attribute__((ext_vector_type(4)));
typedef unsigned v2u __attribute__((ext_vector_type(2)));
typedef float f32x4 __attribute__((ext_vector_type(4)));
typedef float f32x2 __attribute__((ext_vector_type(2)));
typedef GAS unsigned gu32;
#define RLX_AGENT __ATOMIC_RELAXED, __HIP_MEMORY_SCOPE_AGENT
#define LDS_WAIT() asm volatile("s_waitcnt lgkmcnt(0)" ::: "memory")
#define VM_WAIT() asm volatile("s_waitcnt vmcnt(0)" ::: "memory")
typedef __bf16 bf16x2_t __attribute__((ext_vector_type(2)));
__device__ __forceinline__ unsigned pk2(float lo, float hi) { const f32x2 v = {lo, hi}; const bf16x2_t b = __builtin_convertvector(v, bf16x2_t); return __builtin_bit_cast(unsigned, b); }
__device__ __forceinline__ float bflo(unsigned w) { return __uint_as_float(w << 16); }
__device__ __forceinline__ float bfhi(unsigned w) { return __uint_as_float(w & 0xffff0000u); }
__device__ __forceinline__ float bf2f(bf16 h) { return __uint_as_float(((unsigned)h) << 16); }
__device__ __forceinline__ float sigmoidf_(float x) { return __builtin_amdgcn_rcpf(1.0f + __expf(-x)); }
__device__ __forceinline__ float gelu_tanh(float x) { const float z2 = x * (1.5957691216057308f + 0.07135481627260025f * x * x); return x * __builtin_amdgcn_rcpf(1.0f + __expf(-z2)); }
__device__ __forceinline__ float wave_sum(float v) {
#pragma unroll
    for (int o = 1; o < 64; o <<= 1) v += __shfl_xor(v, o);
    return v;
}
__device__ __forceinline__ float wave_max(float v) {
#pragma unroll
    for (int o = 1; o < 64; o <<= 1) v = fmaxf(v, __shfl_xor(v, o));
    return v;
}

#define XB_TMO      128
#define XB_XCNT(j)  (256  + 64 * (j))
#define XB_XSUB(j)  (1280 + 64 * (j))
#define XB_XGEN(j)  (2304 + 64 * (j))
#define XB_TOP      3328
#define XB_TOPGEN   3392
#define XCD_BAR_WORDS 3456
#define XB_SPIN_CAP (1u << 18)

__device__ __forceinline__ unsigned xb_ld(unsigned* p)              { return __hip_atomic_load(p, __ATOMIC_RELAXED, __HIP_MEMORY_SCOPE_AGENT); }
__device__ __forceinline__ unsigned xb_add(unsigned* p, unsigned v) { return __hip_atomic_fetch_add(p, v, __ATOMIC_RELAXED, __HIP_MEMORY_SCOPE_AGENT); }
__device__ __forceinline__ unsigned xb_xcc_id() { return (unsigned)__builtin_amdgcn_s_getreg((3 << 11) | 20) & 0xFu; }
#define XB_SPIN(cond, bar) do { unsigned _sp = 0; while (cond) { __builtin_amdgcn_s_sleep(1); \
    if ((++_sp & 255u) == 0u) { if (xb_ld(&(bar)[XB_TMO])) break; if (_sp > XB_SPIN_CAP) { atomicAdd(&(bar)[XB_TMO], 1u); break; } } } } while (0)

struct XcdBarrier {
    unsigned* bar; unsigned x;
    volatile LAS unsigned* st;
};

__device__ __forceinline__ XcdBarrier xcd_barrier_post(unsigned* bar, volatile LAS unsigned* st) {
    XcdBarrier b; b.bar = bar; b.x = xb_xcc_id(); b.st = st;
    if (threadIdx.x == 0) (void)xb_add(&bar[XB_XCNT(b.x)], 1u);
    return b;
}
__device__ __forceinline__ void xcd_barrier_complete(unsigned* bar, unsigned x, unsigned& nloc, unsigned& nx) {
    const unsigned G = gridDim.x * gridDim.y * gridDim.z;
    unsigned sum, cnt, mine, sp = 0u;
    for (;;) {
        sum = 0u; cnt = 0u; mine = 0u;
#pragma unroll
        for (unsigned j = 0; j < 16; ++j) { const unsigned c = xb_ld(&bar[XB_XCNT(j)]); sum += c; cnt += (c > 0u) ? 1u : 0u; mine = (j == x) ? c : mine; }
        if (sum == G) break;
        __builtin_amdgcn_s_sleep(1);
        if ((++sp & 255u) == 0u) { if (xb_ld(&bar[XB_TMO])) break; if (sp > XB_SPIN_CAP) { atomicAdd(&bar[XB_TMO], 1u); break; } }
    }
    nloc = mine > 0u ? mine : 1u; nx = cnt > 0u ? cnt : 1u;
}

__device__ __forceinline__ void xcd_barrier(const XcdBarrier& b) {
    asm volatile("s_waitcnt vmcnt(0)" ::: "memory");
    __syncthreads();
    if (threadIdx.x == 0) {
        unsigned* bar = b.bar;
        __builtin_amdgcn_s_waitcnt(0);
        unsigned nloc = b.st[0], nx = b.st[1];
        if (nloc == 0u) { xcd_barrier_complete(bar, b.x, nloc, nx); b.st[0] = nloc; b.st[1] = nx; }
        const unsigned old = xb_add(&bar[XB_XSUB(b.x)], 1u);
        const unsigned gen = old / nloc;
        if (old + 1u == (gen + 1u) * nloc) {
            __builtin_amdgcn_fence(__ATOMIC_RELEASE, "agent");
            asm volatile("s_waitcnt vmcnt(0)" ::: "memory");
            const unsigned og = xb_add(&bar[XB_TOP], 1u);
            const unsigned tg = og / nx;
            if (og + 1u == (tg + 1u) * nx) xb_add(&bar[XB_TOPGEN], 1u);
            else XB_SPIN(xb_ld(&bar[XB_TOPGEN]) == tg, bar);
            __builtin_amdgcn_fence(__ATOMIC_ACQUIRE, "agent");
            xb_add(&bar[XB_XGEN(b.x)], 1u);
            asm volatile("s_waitcnt vmcnt(0)" ::: "memory");
        } else {
            XB_SPIN(xb_ld(&bar[XB_XGEN(b.x)]) == gen, bar);
            __builtin_amdgcn_fence(__ATOMIC_ACQUIRE, "agent");
            asm volatile("s_waitcnt vmcnt(0)" ::: "memory");
        }
    }
    __syncthreads();
}

struct Frame {
    LAS unsigned char* lds;
    volatile LAS unsigned* MISC;
    gu32* ctl;
    int tid, lane, wave, vcu, G;
    const float* const* in;
    unsigned char* ws;
};
struct Args { const float* in[33]; float* out; unsigned char* ws; int ph_lo, ph_hi; };
enum { I_X = 0, I_RELB, I_WIN, I_BIN, I_CPOS, I_CW1, I_CB1, I_CW2, I_CB2, I_WATT, I_LRE, I_LIM, I_LDT, I_BRE, I_BIM, I_CRE, I_CIM, I_SD, I_WVAL, I_WGATE, I_BGATE, I_WOUT,
       I_LN1G, I_LN1B, I_RWG, I_RBG, I_RWE, I_RBE, I_EWG, I_EWU, I_EWD, I_LN2G, I_LN2B };

struct TrItem { const float* colp; int ldw, k0, K; bf16* wt; };
__device__ __forceinline__ void tr_load(const TrItem& t, float (&tv)[32], int lane) {
#pragma unroll
    for (int i = 0; i < 32; ++i) { const int kk = 2 * i + (lane >> 5); tv[i] = t.colp ? t.colp[(size_t)(t.k0 + kk) * t.ldw] : 0.f; }
}
__device__ __forceinline__ void tr_store(const TrItem& t, const float (&tv)[32], LAS float* scr, int lane) {
#pragma unroll
    for (int i = 0; i < 32; ++i) { const int kk = 2 * i + (lane >> 5); scr[kk * 33 + (lane & 31)] = tv[i]; }
    LDS_WAIT(); asm volatile("" ::: "memory");
    const int c = lane & 7;
#pragma unroll
    for (int j = 0; j < 4; ++j) { const int n = (lane >> 3) + 8 * j; const LAS float* s = scr + (8 * c) * 33 + n;
        v4u o; o.x = pk2(s[0 * 33], s[1 * 33]); o.y = pk2(s[2 * 33], s[3 * 33]); o.z = pk2(s[4 * 33], s[5 * 33]); o.w = pk2(s[6 * 33], s[7 * 33]);
        *(v4u*)(t.wt + (size_t)n * t.K + 8 * c) = o; }
    LDS_WAIT(); asm volatile("" ::: "memory");
}
__device__ __forceinline__ void tr_item(const float* colp, int ldw, int k0, bf16* wt_row0  , int K, LAS float* scr, int lane) {
    const TrItem t{colp, ldw, k0, K, wt_row0}; float tv[32]; tr_load(t, tv, lane); tr_store(t, tv, scr, lane);
}
__device__ __forceinline__ int proj_src_col(int n) {
    return n < 1280 ? n : (n < 3840 ? n + 24 : (n < 3864 ? n - 3840 + 1280 : -1));
}
__device__ __forceinline__ int t5_bucket(int n) {
    if (n < 16) return n;
    const float nf = (float)n;
    int large = 16 + (int)(logf(nf / 16.0f) / 2.0794415416798357f * 16.0f);
    return large < 31 ? large : 31;
}
__device__ __forceinline__ void p0_prologue(Frame& F, const Args& A) {
    unsigned char* ws = F.ws;
    const int gw = F.vcu * NWAVES + F.wave, NGW = F.G * NWAVES, lane = F.lane;
    if (F.vcu < 32) {
        const int g = F.vcu, tid = F.tid;
        LAS float* pwr = (LAS float*)(F.lds);
        LAS float* pwi = pwr + 17 * 64;
        LAS float* bbr = pwi + 17 * 64;
        LAS float* bbi = bbr + 1024;
        LAS float* ccr = bbi + 1024;
        LAS float* cci = ccr + 1024;
        LAS float* kk  = cci + 1024;
        LAS float* fre = kk + 4096;
        if (tid < 64) {
            const int p = tid; const float lr = A.in[I_LRE][g * 64 + p], li = A.in[I_LIM][g * 64 + p], dt = expf(A.in[I_LDT][g]);
            for (int k = 0; k <= 16; ++k) { const float mag = expf((float)k * lr * dt), ang = (float)k * li * dt; pwr[k * 64 + p] = mag * cosf(ang); pwi[k * 64 + p] = mag * sinf(ang); }
            const float mag = expf(lr * dt), abr = mag * cosf(li * dt), abi = mag * sinf(li * dt), nr = abr - 1.0f, ni = abi, den = lr * lr + li * li;
            fre[p] = (nr * lr + ni * li) / den; fre[64 + p] = (ni * lr - nr * li) / den;
            float* a16 = (float*)(ws + WS_SMALL + SM_A16) + (size_t)(g * 64 + p) * 2; a16[0] = pwr[16 * 64 + p]; a16[1] = pwi[16 * 64 + p];
        }
        __syncthreads();
        for (int e = tid; e < 1024; e += 512) { const int p = e >> 4; const float br = A.in[I_BRE][g * 1024 + e], bi = A.in[I_BIM][g * 1024 + e], fr = fre[p], fi = fre[64 + p];
            bbr[e] = fr * br - fi * bi; bbi[e] = fr * bi + fi * br; ccr[e] = A.in[I_CRE][g * 1024 + e]; cci[e] = A.in[I_CIM][g * 1024 + e]; }
        __syncthreads();
        for (int e = tid; e < 4096; e += 512) { const int d = e >> 8, h = (e >> 4) & 15, h2 = e & 15; float s = 0.f;
            for (int p = 0; p < 64; ++p) { const float cr = ccr[h * 64 + p], ci = cci[h * 64 + p], ar = pwr[d * 64 + p], ai = pwi[d * 64 + p], br = bbr[p * 16 + h2], bi = bbi[p * 16 + h2];
                const float tr = cr * ar - ci * ai, ti = cr * ai + ci * ar; s += tr * br - ti * bi; }
            if (d == 0 && h == h2) s += A.in[I_SD][g * 16 + h];
            kk[e] = s; }
        __syncthreads();
        bf16* CT = (bf16*)(ws + WS_CT) + (size_t)g * 256 * 384;
        for (int v = tid; v < 256 * 48; v += 512) { const int n = v / 48, k0 = (v % 48) * 8, tau = n >> 4, h = n & 15; float o[8];
#pragma unroll
            for (int i = 0; i < 8; ++i) { const int k = k0 + i;
                if (k < 128) { const int p = k & 63; const float cr = ccr[h * 64 + p], ci = cci[h * 64 + p], ar = pwr[(tau + 1) * 64 + p], ai = pwi[(tau + 1) * 64 + p];
                    o[i] = (k < 64) ? (cr * ar - ci * ai) : -(cr * ai + ci * ar); }
                else { const int s = (k - 128) >> 4, h2 = (k - 128) & 15; o[i] = (s <= tau) ? kk[((tau - s) << 8) + (h << 4) + h2] : 0.f; } }
            v4u w; w.x = pk2(o[0], o[1]); w.y = pk2(o[2], o[3]); w.z = pk2(o[4], o[5]); w.w = pk2(o[6], o[7]);
            *(v4u*)(CT + (size_t)n * 384 + k0) = w; }
        bf16* BPT = (bf16*)(ws + WS_BPT) + (size_t)g * 256 * 256;
        for (int v = tid; v < 256 * 32; v += 512) { const int n = v >> 5, k0 = (v & 31) * 8; float o[8];
#pragma unroll
            for (int i = 0; i < 8; ++i) { const int k = k0 + i, s = k >> 4, h2 = k & 15;
                if (n < 128) { const int p = n & 63; const float ar = pwr[(15 - s) * 64 + p], ai = pwi[(15 - s) * 64 + p], br = bbr[p * 16 + h2], bi = bbi[p * 16 + h2];
                    o[i] = (n < 64) ? (ar * br - ai * bi) : (ar * bi + ai * br); }
                else o[i] = 0.f; }
            v4u w; w.x = pk2(o[0], o[1]); w.y = pk2(o[2], o[3]); w.z = pk2(o[4], o[5]); w.w = pk2(o[6], o[7]);
            *(v4u*)(BPT + (size_t)n * 256 + k0) = w; }
        __syncthreads();
    }
    {
        const int gt = F.vcu * (NWAVES * 64) + F.tid;
        float* biasr = (float*)(ws + WS_SMALL + SM_BIASR);
        if (gt < NPROJ) { const int sc = proj_src_col(gt); biasr[gt] = sc >= 0 ? A.in[I_BIN][sc] : 0.f; }
        float* lut = (float*)(ws + WS_SMALL + SM_LUT);
        if (gt >= 8192 && gt < 8192 + 1024) { const int e = gt - 8192, dist = e >> 3, h = e & 7; lut[e] = A.in[I_RELB][t5_bucket(dist) * 8 + h]; }
        bf16* wr = (bf16*)(ws + WS_WRT);
        for (int e = gt; e < 512 * 1024; e += F.G * NWAVES * 64) { const int r = e >> 10, k = e & 1023; int n = -1, lo = 0;
            if (r < 72) n = r; else if (r >= 128 && r < 200) { n = r - 128; lo = 1; } else if (r >= 256 && r < 328) n = r - 256;
            float o = 0.f;
            if (n >= 0) { const float w = n < 8 ? A.in[I_RWG][k * 8 + n] : A.in[I_RWE][k * 64 + (n - 8)]; const float hi = __uint_as_float(pk2(w, 0.f) << 16); o = lo ? w - hi : w; }
            wr[e] = (bf16)(pk2(o, 0.f) & 0xffffu); }
        if (gw >= 1024 && gw < 1024 + 256) { const int o = gw - 1024, j = o >> 7, c = o & 127; float s = 0.f;
            for (int i = lane; i < 2048; i += 64) s += A.in[I_CPOS][j * 2048 + i] * A.in[I_CW1][((size_t)j * 2048 + i) * 128 + c];
            s = wave_sum(s); if (lane == 0) ((float*)(ws + WS_SMALL + SM_B1C))[o] = s + A.in[I_CB1][o]; }
    }
    {
        LAS float* scr = (LAS float*)(F.lds + RING_OFF + 32768 + F.wave * 8704);
        constexpr int I_WI = 16 * 128, I_WA = 8 * 32, I_WV = 8 * 64, I_WO = 16 * 32, I_W1 = 2 * 32 * 8;
        constexpr int NITEMS = I_WI + I_WA + I_WV + I_WO + I_W1;
        const int nl = lane & 31;
        for (int it = gw; it < NITEMS; it += NGW) {
            int r = it;
            if (r < I_WI) { const int kb = r / 128, nb = r % 128, n = nb * 32 + nl, sc = proj_src_col(n);
                tr_item(sc >= 0 ? A.in[I_WIN] + sc : nullptr, D_IN, kb * 64, (bf16*)(ws + WS_WINT) + (size_t)(nb * 32) * 1024 + kb * 64, 1024, scr, lane); continue; } r -= I_WI;
            if (r < I_WA) { const int kb = r / 32, nb = r % 32, n = nb * 32 + nl;
                tr_item(A.in[I_WATT] + n, 1024, kb * 64, (bf16*)(ws + WS_WAT) + (size_t)(nb * 32) * 512 + kb * 64, 512, scr, lane); continue; } r -= I_WA;
            if (r < I_WV) { const int kb = r / 64, nb = r % 64, n = nb * 32 + nl, pn = n >> 8, rr = n & 255;
                const float* src = (rr < 128 ? A.in[I_WVAL] : A.in[I_WGATE]) + pn * 128 + (rr & 127);
                tr_item(src, 1024, kb * 64, (bf16*)(ws + WS_WVGT) + (size_t)(nb * 32) * 512 + kb * 64, 512, scr, lane); continue; } r -= I_WV;
            if (r < I_WO) { const int kb = r / 32, nb = r % 32, n = nb * 32 + nl;
                tr_item(A.in[I_WOUT] + n, 1024, kb * 64, (bf16*)(ws + WS_WOT) + (size_t)(nb * 32) * 1024 + kb * 64, 1024, scr, lane); continue; } r -= I_WO;
            if (r < I_W1) { const int j = r / 256, q = r % 256, kb = q / 8, nb = q % 8, n = nb * 32 + nl;
                tr_item(n < 128 ? A.in[I_CW1] + (size_t)j * 2048 * 128 + n : nullptr, 128, kb * 64, (bf16*)(ws + WS_W1CT) + ((size_t)j * 256 + nb * 32) * 2048 + kb * 64, 2048, scr, lane); }
        }
    }
#pragma unroll 2
    for (int m = gw; m < NTOK; m += NGW) {
        const f32x4* xr = (const f32x4*)(A.in[I_X] + (size_t)m * DM) + lane; v2u* o8 = (v2u*)((bf16*)(ws + WS_XB) + (size_t)m * DM) + lane;
#pragma unroll
        for (int j = 0; j < 4; ++j) { const f32x4 v = xr[64 * j]; v2u w; w.x = pk2(v.x, v.y); w.y = pk2(v.z, v.w); o8[64 * j] = w; }
    }
}

__device__ __forceinline__ TrItem expert_item(const Args& A, unsigned char* ws, int r, int nl) {
    constexpr int I_GU = 64 * 256;
    if (r < I_GU) { const int e = r / 256, q = r % 256, kb = q / 16, nb = q % 16, n = nb * 32 + nl, pn = n >> 8, rr = n & 255;
        const float* src = (rr < 128 ? A.in[I_EWG] : A.in[I_EWU]) + (size_t)e * 1024 * 256 + pn * 128 + (rr & 127);
        return TrItem{src, 256, kb * 64, 1024, (bf16*)(ws + WS_WGUT) + ((size_t)e * 512 + nb * 32) * 1024 + kb * 64}; }
    r -= I_GU;
    const int e = r / 128, q = r % 128, kb = q / 32, nb = q % 32, n = nb * 32 + nl;
    return TrItem{A.in[I_EWD] + (size_t)e * 256 * 1024 + n, 1024, kb * 64, 256, (bf16*)(ws + WS_WDT) + ((size_t)e * 1024 + nb * 32) * 256 + kb * 64};
}
__device__ __forceinline__ void expert_transposes(Frame& F, const Args& A, int wg0) {
    unsigned char* ws = F.ws; const int lane = F.lane, nl = lane & 31;
    LAS float* scr = (LAS float*)(F.lds + RING_OFF + F.wave * 8704);
    constexpr int NIT = 64 * 256 + 64 * 128;
    const int gw = (F.vcu - wg0) * NWAVES + F.wave, NGW = (F.G - wg0) * NWAVES;
    float ta[32], tb[32];
    int it = gw;
    if (it < NIT) { TrItem cur = expert_item(A, ws, it, nl); tr_load(cur, ta, lane);
#pragma unroll 1
        for (;;) {
            const int it2 = it + NGW; TrItem nxt = cur;
            if (it2 < NIT) { nxt = expert_item(A, ws, it2, nl); tr_load(nxt, tb, lane); }
            tr_store(cur, ta, scr, lane);
            if (it2 >= NIT) break;
            const int it3 = it2 + NGW; cur = nxt;
            if (it3 < NIT) { cur = expert_item(A, ws, it3, nl); tr_load(cur, ta, lane); }
            tr_store(nxt, tb, scr, lane);
            if (it3 >= NIT) break;
            it = it3;
        }
    }
    __syncthreads();
}

typedef pg8::f32x4 (AccT)[2][2][4][2];
constexpr float QSCALE = 0.125f * 1.4426950408889634f;
struct EpiProj {
    static constexpr bool PERM = true, AFTER_DRAIN = false;
    bf16 *Q, *KV, *SA, *MG, *G; const float* bias;
    __device__ __forceinline__ void operator()(const AccT& acc, const pg8::Unit& u, int wr, int wc, int fr, int fq) const {
        const int pn = u.pn, row0 = u.pm * 256 + wr * 64 + fr;
#pragma unroll
        for (int bj = 0; bj < 2; ++bj) {
            const int cl = bj * 128 + wc * 32 + 8 * fq, nc = pn * 256 + cl;
            const f32x4 b0 = *(const f32x4*)(bias + nc), b1 = *(const f32x4*)(bias + nc + 4);
#pragma unroll
            for (int ai = 0; ai < 2; ++ai)
#pragma unroll
                for (int m = 0; m < 4; ++m) {
                    const int row = row0 + ai * 128 + m * 16;
                    f32x4 v0 = acc[ai][bj][m][0] + b0, v1 = acc[ai][bj][m][1] + b1;
                    bf16* dst;
                    if (pn < 2) { v0 = v0 * QSCALE; v1 = v1 * QSCALE; dst = Q + (size_t)row * 512 + nc; }
                    else if (pn < 5) { const int kc = nc - 512, j = kc >> 7, g = (kc >> 6) & 1, d = kc & 63, b = row >> 12, t = row & 4095; dst = KV + ((((size_t)j * 8 + b) * 2 + g) * 4096 + t) * 64 + d; }
                    else if (pn < 7) { const int uc = nc - 1280, grp = uc >> 4, h = uc & 15, b = row >> 12, t = row & 4095; dst = SA + ((size_t)grp * 2048 + b * 256 + (t >> 4)) * 384 + 128 + (t & 15) * 16 + h; }
                    else {
                        v0.x = sigmoidf_(v0.x); v0.y = sigmoidf_(v0.y); v0.z = sigmoidf_(v0.z); v0.w = sigmoidf_(v0.w);
                        v1.x = sigmoidf_(v1.x); v1.y = sigmoidf_(v1.y); v1.z = sigmoidf_(v1.z); v1.w = sigmoidf_(v1.w);
                        if (pn < 15) dst = MG + (size_t)row * 2048 + (nc - 1792);
                        else { if (cl >= 24) continue; dst = G + (size_t)row * 32 + cl; }
                    }
                    v4u w; w.x = pk2(v0.x, v0.y); w.y = pk2(v0.z, v0.w); w.z = pk2(v1.x, v1.y); w.w = pk2(v1.z, v1.w);
                    *(v4u*)dst = w;
                }
        }
    }
};
template <bool GELU> struct EpiF32Half {
    static constexpr bool PERM = false, AFTER_DRAIN = false;
    float* O; const float* bias;
    __device__ __forceinline__ void operator()(const AccT& acc, const pg8::Unit& u, int wr, int wc, int fr, int fq) const {
        const int row0 = u.pm * 256 + wr * 64 + fr;
#pragma unroll
        for (int n = 0; n < 2; ++n) {
            const int c = wc * 32 + 16 * n + 4 * fq;
            f32x4 bv = (f32x4){0.f, 0.f, 0.f, 0.f}; if (bias) bv = *(const f32x4*)(bias + u.pn * 128 + c);
#pragma unroll
            for (int ai = 0; ai < 2; ++ai)
#pragma unroll
                for (int m = 0; m < 4; ++m) { f32x4 v = acc[ai][0][m][n] + bv;
                    if (GELU) { v.x = gelu_tanh(v.x); v.y = gelu_tanh(v.y); v.z = gelu_tanh(v.z); v.w = gelu_tanh(v.w); }
                    *(f32x4*)(O + (size_t)(row0 + ai * 128 + m * 16) * 128 + c) = v; }
        }
    }
};
struct EpiS5Y {
    static constexpr bool PERM = true, AFTER_DRAIN = false;
    bf16* Z;
    __device__ __forceinline__ void operator()(const AccT& acc, const pg8::Unit& u, int wr, int wc, int fr, int fq) const {
        const int g = u.pn, b = u.pm & 7, ch0 = wr * 64 + fr;
#pragma unroll
        for (int bj = 0; bj < 2; ++bj) { const int n0 = bj * 128 + wc * 32 + 8 * fq, tau = n0 >> 4, h = n0 & 15;
            bf16* zp = Z + ((size_t)b * 4096 + ch0 * 16 + tau) * 512 + g * 16 + h;
#pragma unroll
            for (int ai = 0; ai < 2; ++ai)
#pragma unroll
                for (int m = 0; m < 4; ++m) {
                    const f32x4 v0 = acc[ai][bj][m][0], v1 = acc[ai][bj][m][1];
                    v4u w; w.x = pk2(gelu_tanh(v0.x), gelu_tanh(v0.y)); w.y = pk2(gelu_tanh(v0.z), gelu_tanh(v0.w)); w.z = pk2(gelu_tanh(v1.x), gelu_tanh(v1.y)); w.w = pk2(gelu_tanh(v1.z), gelu_tanh(v1.w));
                    *(v4u*)(zp + (size_t)(ai * 128 + m * 16) * 16 * 512) = w; asm volatile("" ::: "memory"); } }
    }
};
struct EpiYa {
    static constexpr bool PERM = true, AFTER_DRAIN = false;
    bf16* T; const bf16* MG;
    __device__ __forceinline__ void operator()(const AccT& acc, const pg8::Unit& u, int wr, int wc, int fr, int fq) const {
        const int row0 = u.pm * 256 + wr * 64 + fr;
#pragma unroll
        for (int bj = 0; bj < 2; ++bj) { const int col = u.pn * 256 + bj * 128 + wc * 32 + 8 * fq;
#pragma unroll
            for (int ai = 0; ai < 2; ++ai)
#pragma unroll
                for (int m = 0; m < 4; ++m) { const int row = row0 + ai * 128 + m * 16;
                    const v4u g = *(const v4u*)(MG + (size_t)row * 2048 + col); const f32x4 v0 = acc[ai][bj][m][0], v1 = acc[ai][bj][m][1];
                    v4u w; w.x = pk2(v0.x * bflo(g.x), v0.y * bfhi(g.x)); w.y = pk2(v0.z * bflo(g.y), v0.w * bfhi(g.y)); w.z = pk2(v1.x * bflo(g.z), v1.y * bfhi(g.z)); w.w = pk2(v1.z * bflo(g.w), v1.w * bfhi(g.w));
                    *(v4u*)(T + (size_t)row * 1024 + col) = w; } }
    }
};
struct EpiYb {
    static constexpr bool PERM = true, AFTER_DRAIN = false;
    const bf16* T; const bf16* MG; const float* bg; bf16* MX;
    __device__ __forceinline__ void operator()(const AccT& acc, const pg8::Unit& u, int wr, int wc, int fr, int fq) const {
        const int row0 = u.pm * 256 + wr * 64 + fr, col = u.pn * 128 + wc * 32 + 8 * fq;
        const f32x4 b0 = *(const f32x4*)(bg + col), b1 = *(const f32x4*)(bg + col + 4);
#pragma unroll
        for (int ai = 0; ai < 2; ++ai)
#pragma unroll
            for (int m = 0; m < 4; ++m) { const int row = row0 + ai * 128 + m * 16;
                const v4u g = *(const v4u*)(MG + (size_t)row * 2048 + 1024 + col); const v4u t = *(const v4u*)(T + (size_t)row * 1024 + col);
                const f32x4 a0 = acc[ai][0][m][0], a1 = acc[ai][0][m][1], g0 = acc[ai][1][m][0] + b0, g1 = acc[ai][1][m][1] + b1;
                float o[8];
                o[0] = bflo(t.x) + bflo(g.x) * a0.x * sigmoidf_(g0.x); o[1] = bfhi(t.x) + bfhi(g.x) * a0.y * sigmoidf_(g0.y);
                o[2] = bflo(t.y) + bflo(g.y) * a0.z * sigmoidf_(g0.z); o[3] = bfhi(t.y) + bfhi(g.y) * a0.w * sigmoidf_(g0.w);
                o[4] = bflo(t.z) + bflo(g.z) * a1.x * sigmoidf_(g1.x); o[5] = bfhi(t.z) + bfhi(g.z) * a1.y * sigmoidf_(g1.y);
                o[6] = bflo(t.w) + bflo(g.w) * a1.z * sigmoidf_(g1.z); o[7] = bfhi(t.w) + bfhi(g.w) * a1.w * sigmoidf_(g1.w);
                v4u w; w.x = pk2(o[0], o[1]); w.y = pk2(o[2], o[3]); w.z = pk2(o[4], o[5]); w.w = pk2(o[6], o[7]);
                *(v4u*)(MX + (size_t)row * 1024 + col) = w; }
    }
};
struct EpiOut {
    static constexpr bool PERM = false, AFTER_DRAIN = false;
    const float* X; float* V;
    __device__ __forceinline__ void operator()(const AccT& acc, const pg8::Unit& u, int wr, int wc, int fr, int fq) const {
        const int row0 = u.pm * 256 + wr * 64 + fr;
#pragma unroll
        for (int bj = 0; bj < 2; ++bj)
#pragma unroll
            for (int n = 0; n < 2; ++n) { const int col = u.pn * 256 + bj * 128 + wc * 32 + 16 * n + 4 * fq;
#pragma unroll
                for (int ai = 0; ai < 2; ++ai)
#pragma unroll
                    for (int m = 0; m < 4; ++m) { const size_t o = (size_t)(row0 + ai * 128 + m * 16) * 1024 + col;
                        const f32x4 x = *(const f32x4*)(X + o); *(f32x4*)(V + o) = x * DN_ALPHA + acc[ai][bj][m][n]; } }
    }
};
struct EpiMoe1 {
    static constexpr bool PERM = true, AFTER_DRAIN = false;
    bf16* HB;
    __device__ __forceinline__ void operator()(const AccT& acc, const pg8::Unit& u, int wr, int wc, int fr, int fq) const {
        const int row0 = u.pm * 256 + wr * 64 + fr, col = (u.pn & 1) * 128 + wc * 32 + 8 * fq;
#pragma unroll
        for (int ai = 0; ai < 2; ++ai)
#pragma unroll
            for (int m = 0; m < 4; ++m) { const f32x4 g0 = acc[ai][0][m][0], g1 = acc[ai][0][m][1], u0 = acc[ai][1][m][0], u1 = acc[ai][1][m][1];
                v4u w; w.x = pk2(g0.x * sigmoidf_(g0.x) * u0.x, g0.y * sigmoidf_(g0.y) * u0.y); w.y = pk2(g0.z * sigmoidf_(g0.z) * u0.z, g0.w * sigmoidf_(g0.w) * u0.w);
                w.z = pk2(g1.x * sigmoidf_(g1.x) * u1.x, g1.y * sigmoidf_(g1.y) * u1.y); w.w = pk2(g1.z * sigmoidf_(g1.z) * u1.z, g1.w * sigmoidf_(g1.w) * u1.w);
                *(v4u*)(HB + (size_t)(row0 + ai * 128 + m * 16) * 256 + col) = w; }
    }
};
struct EpiMoe2 {
    static constexpr bool PERM = true, AFTER_DRAIN = false;
    bf16* Y;
    __device__ __forceinline__ void operator()(const AccT& acc, const pg8::Unit& u, int wr, int wc, int fr, int fq) const {
        const int row0 = u.pm * 256 + wr * 64 + fr;
#pragma unroll
        for (int bj = 0; bj < 2; ++bj) { const int col = (u.pn & 3) * 256 + bj * 128 + wc * 32 + 8 * fq;
#pragma unroll
            for (int ai = 0; ai < 2; ++ai)
#pragma unroll
                for (int m = 0; m < 4; ++m) { const f32x4 v0 = acc[ai][bj][m][0], v1 = acc[ai][bj][m][1];
                    v4u w; w.x = pk2(v0.x, v0.y); w.y = pk2(v0.z, v0.w); w.z = pk2(v1.x, v1.y); w.w = pk2(v1.z, v1.w);
                    *(v4u*)(Y + (size_t)(row0 + ai * 128 + m * 16) * 1024 + col) = w; } }
    }
};
struct EpiRouter {
    static constexpr bool PERM = false, AFTER_DRAIN = true;
    const float* bg; const float* be; int* route; int* hist;
    __device__ __forceinline__ void fused(const AccT& acc, const pg8::Unit& u, int wr, int wc, int fr, int fq, PG8_LAS unsigned char* lds, int wid, int lane) const {
        PG8_LAS float* LG = (PG8_LAS float*)lds;
        PG8_LAS int* lh = (PG8_LAS int*)(lds + 256 * 76 * 4);
        const int tid = wid * 64 + lane;
        if (tid < 64) lh[tid] = 0;
        if (wc < 3) {
#pragma unroll
            for (int n = 0; n < 2; ++n) { const int c = wc * 32 + 16 * n + 4 * fq;
                if (c < 72) {
#pragma unroll
                    for (int ai = 0; ai < 2; ++ai)
#pragma unroll
                        for (int m = 0; m < 4; ++m) { const pg8::f32x4 v = acc[ai][0][m][n] + acc[ai][1][m][n]; *(PG8_LAS pg8::f32x4*)(LG + (ai * 128 + wr * 64 + m * 16 + fr) * 76 + c) = v; } } }
        }
        asm volatile("s_waitcnt lgkmcnt(0)" ::: "memory"); __builtin_amdgcn_s_barrier(); asm volatile("" ::: "memory");
        const int wg = u.pm - 128;
        if (tid < 256) {
            const PG8_LAS float* l = LG + tid * 76; const int row = wg * 256 + tid;
            float gm = -3.0e38f; int gi = 0; float gl[8];
#pragma unroll
            for (int j = 0; j < 8; ++j) { gl[j] = l[j] + bg[j]; if (gl[j] > gm) { gm = gl[j]; gi = j; } }
            float ge = 0.f;
#pragma unroll
            for (int j = 0; j < 8; ++j) ge += __expf(gl[j] - gm);
            const float pgroup = 1.0f / ge;
            float m1 = -3.0e38f, m2 = -3.0e38f; int i1 = 0, i2 = 0;
#pragma unroll
            for (int j = 0; j < 8; ++j) { const float v = l[8 + gi * 8 + j] + be[gi * 8 + j];
                if (v > m1) { m2 = m1; i2 = i1; m1 = v; i1 = j; } else if (v > m2) { m2 = v; i2 = j; } }
            const float e2 = __expf(m2 - m1), w1 = pgroup / (1.0f + e2), w2 = pgroup * e2 / (1.0f + e2);
            int* rt = route + (size_t)row * 8; const int ex1 = gi * 8 + i1, ex2 = gi * 8 + i2;
            const int r1 = __hip_atomic_fetch_add(lh + ex1, 1, __ATOMIC_RELAXED, __HIP_MEMORY_SCOPE_WORKGROUP), r2 = __hip_atomic_fetch_add(lh + ex2, 1, __ATOMIC_RELAXED, __HIP_MEMORY_SCOPE_WORKGROUP);
            rt[0] = ex1; rt[1] = ex2; rt[2] = __float_as_int(w1); rt[3] = __float_as_int(w2); rt[4] = r1; rt[5] = r2;
        }
        asm volatile("s_waitcnt lgkmcnt(0)" ::: "memory"); __builtin_amdgcn_s_barrier(); asm volatile("" ::: "memory");
        if (tid < 64) hist[wg * 64 + tid] = lh[tid];
    }
};
struct RouterOrder {
    int c;
    __device__ __forceinline__ bool next(int i, pg8::Unit& u) const { if (c >= 128 || i >= 2) return false; u.pm = c + 128 * i; u.pn = i; return true; }
    __device__ __forceinline__ void a_ready(const pg8::Unit&) const {}
    __device__ __forceinline__ void done(const pg8::Unit&) const {}
};
struct ListOrder {
    int n, G, c, per, div;
    __device__ __forceinline__ bool next(int i, pg8::Unit& u) const { const int L = i * G + c; if (L >= n) return false; u.pm = L / per; u.pn = (u.pm / div) * per + L % per; return true; }
    __device__ __forceinline__ void a_ready(const pg8::Unit&) const {}
    __device__ __forceinline__ void done(const pg8::Unit&) const {}
};
struct MoeOrder {
    int n, G, c, per; const LAS unsigned char* tile_e;
    __device__ __forceinline__ bool next(int i, pg8::Unit& u) const { const int L = i * G + c; if (L >= n) return false; u.pm = L / per; u.pn = (int)tile_e[u.pm] * per + L % per; return true; }
    __device__ __forceinline__ void a_ready(const pg8::Unit&) const {}
    __device__ __forceinline__ void done(const pg8::Unit&) const {}
};

__device__ __forceinline__ void p3_thin(Frame& F, const Args& A) {
    unsigned char* ws = F.ws;
    {
        const float* HID = (const float*)(ws + WS_HID); bf16* KC = (bf16*)(ws + WS_KC);
        const int total = 2 * 4096 * 64;
        for (int o = F.vcu * 512 + F.tid; o < total; o += F.G * 512) {
            const int d = o & 63, row = o >> 6, j = row >> 12;
            const float* h = HID + (size_t)row * 128; const float* w = A.in[I_CW2] + (size_t)j * 128 * 64 + d;
            float s = A.in[I_CB2][j * 64 + d];
#pragma unroll 8
            for (int m = 0; m < 128; ++m) s += h[m] * w[m * 64];
            KC[o] = (bf16)(pk2(s, 0.f) & 0xffffu);
        }
    }
    if (F.wave == 0) {
        for (int gb = F.vcu; gb < 256; gb += F.G) {
            const int p = F.lane; const float* a16 = (const float*)(ws + WS_SMALL + SM_A16) + (size_t)((gb >> 3) * 64 + p) * 2; const float ar = a16[0], ai = a16[1];
            const float* E = (const float*)(ws + WS_E) + (size_t)gb * 256 * 128; bf16* SA = (bf16*)(ws + WS_SA) + (size_t)gb * 256 * 384;
            float xr = 0.f, xi = 0.f;
            for (int c0 = 0; c0 < 256; c0 += 8) {
                float er[8], ei[8];
#pragma unroll
                for (int k = 0; k < 8; ++k) { er[k] = E[(size_t)(c0 + k) * 128 + p]; ei[k] = E[(size_t)(c0 + k) * 128 + 64 + p]; }
#pragma unroll
                for (int k = 0; k < 8; ++k) { bf16* row = SA + (size_t)(c0 + k) * 384; row[p] = (bf16)(pk2(xr, 0.f) & 0xffffu); row[64 + p] = (bf16)(pk2(xi, 0.f) & 0xffffu);
                    const float nr = ar * xr - ai * xi + er[k], ni = ar * xi + ai * xr + ei[k]; xr = nr; xi = ni; }
            }
        }
    }
}


namespace att2 {
typedef short bf16x8 __attribute__((ext_vector_type(8)));
typedef short s16x4 __attribute__((ext_vector_type(4)));
typedef float f32x16 __attribute__((ext_vector_type(16)));
typedef short v4i16_t __attribute__((ext_vector_type(4)));
typedef LAS const char* lds_cptr;
#define A2_MFMA(a, b, c) __builtin_amdgcn_mfma_f32_32x32x16_bf16(a, b, c, 0, 0, 0)
constexpr int SLOTB = 8192, NSLOT = 4, L_K = 0, L_V = NSLOT * SLOTB, L_LUT = 2 * NSLOT * SLOTB, L_WS = L_LUT + 4096, WS_PER_WAVE = 7168;
constexpr int W_WSF = 0, W_TBL = 128, W_GATE = 256, W_IMP = 768, W_OST = 3072;
static_assert(L_WS + 8 * WS_PER_WAVE <= 131072, "attention LDS map");
constexpr float MASKED = -2.0e30f, MINIT = -1.0e30f, THR = 8.0f;
__device__ __forceinline__ int crow(int r, int hi) { return (r & 3) + 8 * (r >> 2) + 4 * hi; }
__device__ __forceinline__ s16x4 vtr(lds_cptr p) { return __builtin_bit_cast(s16x4, __builtin_amdgcn_ds_read_tr16_b64_v4i16((LAS v4i16_t*)p)); }
#define A2_MX3(a, b, c) __builtin_fmaxf(__builtin_fmaxf((a), (b)), (c))
__device__ __forceinline__ float rowmax(const f32x16& p0, const f32x16& p1) {
    float a = A2_MX3(p0[0], p0[1], p1[0]), b = A2_MX3(p0[2], p0[3], p1[1]); a = A2_MX3(a, p1[2], p1[3]);
#pragma unroll
    for (int r = 4; r < 16; r += 4) { a = A2_MX3(a, p0[r], p0[r + 1]); b = A2_MX3(b, p0[r + 2], p0[r + 3]); a = A2_MX3(a, p1[r], p1[r + 1]); b = A2_MX3(b, p1[r + 2], p1[r + 3]); }
    const float m = __builtin_fmaxf(a, b); auto rr = __builtin_amdgcn_permlane32_swap(__float_as_uint(m), __float_as_uint(m), false, false);
    return __builtin_fmaxf(__uint_as_float(rr[0]), __uint_as_float(rr[1])); }
__device__ __forceinline__ float halfsum(float v) { auto rr = __builtin_amdgcn_permlane32_swap(__float_as_uint(v), __float_as_uint(v), false, false); return __uint_as_float(rr[0]) + __uint_as_float(rr[1]); }

struct Ctx {
    LAS unsigned char* lds;
    int wid, lane, r32, hi;
    int tq;
    int hg;
    bf16x8 qr[4];
};
__device__ __forceinline__ void glds16(const void* g, unsigned lds_base) {
    unsigned sv; asm volatile("s_mov_b32 %0, m0\n\ts_mov_b32 m0, %2\n\ts_nop 0\n\tglobal_load_lds_dwordx4 %1, off\n\ts_mov_b32 m0, %0" : "=&s"(sv) : "v"(g), "s"(lds_base) : "memory"); }
__device__ __forceinline__ void stage(const Ctx& C, const bf16* ksrc, const bf16* vsrc, int slot) {
    const unsigned base = (unsigned)(uintptr_t)C.lds + (unsigned)(slot * SLOTB + C.wid * 1024);
    glds16(ksrc + (size_t)C.lane * 64 + C.wid * 8, (unsigned)__builtin_amdgcn_readfirstlane((int)(base + L_K)));
    glds16(vsrc + (size_t)(16 * (C.wid & 3) + (C.lane >> 2)) * 64 + (C.wid >> 2) * 32 + (C.lane & 3) * 8, (unsigned)__builtin_amdgcn_readfirstlane((int)(base + L_V)));
}
struct Pipe {
    const bf16 *KV, *KC; int w;
    int k, pass, idx, n; const bf16 *kb, *vb;
    int issued, s;
    __device__ __forceinline__ int qt_of(int kk) const { const int r = w & 15; return kk == 0 ? r : (kk == 1 ? 31 - r : (kk == 2 ? 32 + r : 63 - r)); }
    __device__ __forceinline__ void setup_pass() {
        const int bg = w >> 4, qt = qt_of(k); const size_t kvslab = (size_t)bg * 4096 * 64, kvstride = (size_t)NB * 2 * 4096 * 64;
        if (pass < 2) { n = (4 * qt + 66) >> 6; kb = KC + (size_t)bg * 256 * 64; vb = kb + (size_t)16 * 256 * 64; }
        else if (pass == 2) { n = qt + 1; kb = KV + 2 * kvstride + kvslab; vb = kb + kvstride; }
        else { const int j0 = qt > 8 ? qt - 8 : 0; n = qt - j0 + 1; kb = KV + 4 * kvstride + kvslab + (size_t)j0 * 4096; vb = kb + kvstride; }
    }
    __device__ __forceinline__ void init(const bf16* KV_, const bf16* KC_, int w_) { KV = KV_; KC = KC_; w = w_; k = 0; pass = 0; idx = 0; issued = 0; s = 0; setup_pass(); }
    __device__ __forceinline__ void issue_next(const Ctx& C) {
        if (k < 4) { stage(C, kb + (size_t)idx * 4096, vb + (size_t)idx * 4096, issued & (NSLOT - 1)); ++issued; ++idx;
            if (idx == n) { idx = 0; ++pass; if (pass == 4) { pass = 0; ++k; } if (k < 4) setup_pass(); } }
    }
    __device__ __forceinline__ void wait_bar(int pending) {
        if (pending >= 2) asm volatile("s_waitcnt vmcnt(4) lgkmcnt(0)" ::: "memory"); else if (pending == 1) asm volatile("s_waitcnt vmcnt(2) lgkmcnt(0)" ::: "memory"); else asm volatile("s_waitcnt vmcnt(0) lgkmcnt(0)" ::: "memory");
        __builtin_amdgcn_s_barrier(); asm volatile("" ::: "memory");
    }
    __device__ __forceinline__ void prologue(const Ctx& C) { issue_next(C); issue_next(C); wait_bar(issued - 1); }
    __device__ __forceinline__ int slot() const { return s & (NSLOT - 1); }
    __device__ __forceinline__ void begin_step(const Ctx& C) { issue_next(C); }
    __device__ __forceinline__ void end_step() { wait_bar(issued - (s + 2)); ++s; }
};
__device__ __forceinline__ void scores(const Ctx& C, int slot, f32x16& s0, f32x16& s1) {
    const lds_cptr kp = (lds_cptr)C.lds + L_K + slot * SLOTB + C.hi * 1024 + C.r32 * 16;
    bf16x8 kf[8];
#pragma unroll
    for (int d0 = 0; d0 < 4; ++d0) { kf[2 * d0] = *(const LAS bf16x8*)(kp + d0 * 2048); kf[2 * d0 + 1] = *(const LAS bf16x8*)(kp + d0 * 2048 + 512); }
    f32x16 z;
#pragma unroll
    for (int i = 0; i < 16; ++i) z[i] = 0.f;
    s0 = A2_MFMA(kf[0], C.qr[0], z); s1 = A2_MFMA(kf[1], C.qr[0], z);
    s0 = A2_MFMA(kf[2], C.qr[1], s0); s1 = A2_MFMA(kf[3], C.qr[1], s1);
    s0 = A2_MFMA(kf[4], C.qr[2], s0); s1 = A2_MFMA(kf[5], C.qr[2], s1);
    s0 = A2_MFMA(kf[6], C.qr[3], s0); s1 = A2_MFMA(kf[7], C.qr[3], s1);
}
__device__ __forceinline__ void bias_far(f32x16& s0, f32x16& s1, float cl) {
#pragma unroll
    for (int r = 0; r < 16; ++r) { s0[r] += cl; s1[r] += cl; }
}
__device__ __forceinline__ void bias_near(const Ctx& C, f32x16& s0, f32x16& s1, int kbase, int kstep, int maxd, bool colsel) {
    const LAS float* lut = (const LAS float*)(C.lds + L_LUT) + C.hg;
    const int d0 = C.tq - kbase - kstep * 4 * C.hi;
#pragma unroll
    for (int half = 0; half < 2; ++half) {
        f32x16& sx = half ? s1 : s0; const int dh = d0 - half * 32 * kstep;
        float bb[16];
#pragma unroll
        for (int r = 0; r < 16; ++r) { const int da = dh - kstep * ((r & 3) + 8 * (r >> 2)); const int ia = da < 0 ? 0 : (da > 127 ? 127 : da); bb[r] = lut[ia * 8]; }
#pragma unroll
        for (int r = 0; r < 16; ++r) { const int da = dh - kstep * ((r & 3) + 8 * (r >> 2)); const bool ok = colsel && da >= 0 && da <= maxd; const float v = sx[r] + bb[r]; sx[r] = ok ? v : MASKED; }
    }
}
struct Acc { f32x16 o[2]; float m, l; };
__device__ __forceinline__ void acc_zero(Acc& a) {
#pragma unroll
    for (int i = 0; i < 16; ++i) { a.o[0][i] = 0.f; a.o[1][i] = 0.f; }
    a.m = MINIT; a.l = 0.f;
}
__device__ __forceinline__ void pack_p(const f32x16& p0, const f32x16& p1, v4u (&pw)[4]) {
#pragma unroll
    for (int k = 0; k < 2; ++k) { pw[k] = (v4u){pk2(p0[8 * k], p0[8 * k + 1]), pk2(p0[8 * k + 2], p0[8 * k + 3]), pk2(p0[8 * k + 4], p0[8 * k + 5]), pk2(p0[8 * k + 6], p0[8 * k + 7])};
                                  pw[2 + k] = (v4u){pk2(p1[8 * k], p1[8 * k + 1]), pk2(p1[8 * k + 2], p1[8 * k + 3]), pk2(p1[8 * k + 4], p1[8 * k + 5]), pk2(p1[8 * k + 6], p1[8 * k + 7])}; }
}
__device__ __forceinline__ void pv_packed(const Ctx& C, int slot, const v4u (&pw)[4], f32x16 (&o)[2]) {
    const lds_cptr vp = (lds_cptr)C.lds + L_V + slot * SLOTB + ((C.lane >> 4) & 1) * 32 + (C.lane & 3) * 8 + (4 * C.hi + ((C.lane & 15) >> 2)) * 64;
#pragma unroll
    for (int dh = 0; dh < 2; ++dh) {
        s16x4 vlo[4], vhi[4];
#pragma unroll
        for (int k = 0; k < 4; ++k) { vlo[k] = vtr(vp + dh * 4096 + k * 1024); vhi[k] = vtr(vp + dh * 4096 + k * 1024 + 512); }
#pragma unroll
        for (int k = 0; k < 4; ++k) { const bf16x8 vf = (bf16x8){vlo[k][0], vlo[k][1], vlo[k][2], vlo[k][3], vhi[k][0], vhi[k][1], vhi[k][2], vhi[k][3]};
            o[dh] = A2_MFMA(__builtin_bit_cast(bf16x8, pw[k]), vf, o[dh]); }
    }
}
__device__ __forceinline__ void pv(const Ctx& C, int slot, const f32x16& p0, const f32x16& p1, f32x16 (&o)[2]) { v4u pw[4]; pack_p(p0, p1, pw); pv_packed(C, slot, pw, o); }
__device__ __forceinline__ void softmax_step(const Ctx& C, Acc& a, f32x16& s0, f32x16& s1, float cl) {
    LAS float* wsf = (LAS float*)(C.lds + L_WS + C.wid * WS_PER_WAVE + W_WSF);
    const float mt = rowmax(s0, s1) + cl;
    if (__any(mt - a.m > THR)) {
        const float mn = __builtin_fmaxf(a.m, mt), f = __builtin_amdgcn_exp2f(a.m - mn);
        a.l *= f; a.m = mn;
        if (C.hi == 0) wsf[C.r32] = f;
        asm volatile("s_waitcnt lgkmcnt(0)" ::: "memory");
#pragma unroll
        for (int r = 0; r < 16; ++r) { const float fr = wsf[crow(r, C.hi)]; a.o[0][r] *= fr; a.o[1][r] *= fr; }
        asm volatile("s_waitcnt lgkmcnt(0)" ::: "memory");
    }
    const float nm = cl - a.m; float sacc = 0.f;
#pragma unroll
    for (int r = 0; r < 16; ++r) { s0[r] = __builtin_amdgcn_exp2f(s0[r] + nm); s1[r] = __builtin_amdgcn_exp2f(s1[r] + nm); sacc += s0[r] + s1[r]; }
    a.l += sacc;
}
__device__ __forceinline__ void fold(const Ctx& C, const Acc& a, int branch, f32x16 (&out)[2]) {
    LAS float* tbl = (LAS float*)(C.lds + L_WS + C.wid * WS_PER_WAVE + W_TBL);
    const LAS float* gate = (const LAS float*)(C.lds + L_WS + C.wid * WS_PER_WAVE + W_GATE);
    const float l = halfsum(a.l);
    if (C.hi == 0) tbl[C.r32] = (l > 0.f ? __builtin_amdgcn_rcpf(l) : 0.f) * gate[C.r32 * 4 + branch];
    asm volatile("s_waitcnt lgkmcnt(0)" ::: "memory");
#pragma unroll
    for (int r = 0; r < 16; ++r) { const float f = tbl[crow(r, C.hi)]; out[0][r] += f * a.o[0][r]; out[1][r] += f * a.o[1][r]; }
    asm volatile("s_waitcnt lgkmcnt(0)" ::: "memory");
}

__device__ __forceinline__ void unit(Ctx& C, Pipe& P, int b, int g, int qt, const bf16* Q, const bf16* GT, bf16* O) {
    LAS unsigned char* lds = C.lds; const int wid = C.wid, lane = C.lane;
    const int t0 = qt * 64, ql = C.r32 >> 2, hl = C.r32 & 3;
    C.tq = t0 + 8 * wid + ql; C.hg = g * 4 + hl;
    const size_t row = (size_t)b * 4096 + C.tq;
    LAS unsigned char* wsb = lds + L_WS + wid * WS_PER_WAVE;
#pragma unroll
    for (int d0 = 0; d0 < 4; ++d0) C.qr[d0] = *(const bf16x8*)(Q + row * 512 + C.hg * 64 + d0 * 16 + C.hi * 8);
    if (C.hi == 0) { LAS float* gate = (LAS float*)(wsb + W_GATE);
#pragma unroll
        for (int br = 0; br < 3; ++br) gate[C.r32 * 4 + br] = bf2f(GT[row * 32 + C.hg * 3 + br]); }
    { LAS float* imp = (LAS float*)(wsb + W_IMP);
#pragma unroll
        for (int i = 0; i < 8; ++i) imp[lane + 64 * i] = 0.f; }
    const float lut31 = ((const LAS float*)(lds + L_LUT))[127 * 8 + C.hg];
    f32x16 out[2];
#pragma unroll
    for (int i = 0; i < 16; ++i) { out[0][i] = 0.f; out[1][i] = 0.f; }
    Acc a; f32x16 s0, s1;
    const int tmax = t0 + 63, nvis_max = tmax >= 31 ? ((tmax - 31) >> 4) + 1 : 0, ntc = (nvis_max + 63) >> 6;
    const int twmin = t0 + 8 * wid;
    float mc = MINIT, lc = 0.f;
#pragma unroll 1
    for (int tl = 0; tl < ntc; ++tl) {
        P.begin_step(C);
        scores(C, P.slot(), s0, s1);
        float cl = 0.f;
        if (twmin - (16 * (64 * tl + 63) + 31) >= 113) cl = lut31; else bias_near(C, s0, s1, 16 * 64 * tl + 31, 16, 1 << 30, true);
        const float mt = rowmax(s0, s1) + cl, mn = __builtin_fmaxf(mc, mt); float sacc = 0.f; const float nm = cl - mn;
#pragma unroll
        for (int r = 0; r < 16; ++r) sacc += __builtin_amdgcn_exp2f(s0[r] + nm) + __builtin_amdgcn_exp2f(s1[r] + nm);
        lc = lc * __builtin_amdgcn_exp2f(mc - mn) + sacc; mc = mn;
        P.end_step();
    }
    { const float lf = halfsum(lc); lc = lf > 0.f ? __builtin_amdgcn_rcpf(lf) : 0.f; }
    acc_zero(a);
#pragma unroll 1
    for (int tl = 0; tl < ntc; ++tl) {
        P.begin_step(C);
        scores(C, P.slot(), s0, s1);
        float cl = 0.f;
        if (twmin - (16 * (64 * tl + 63) + 31) >= 113) cl = lut31; else bias_near(C, s0, s1, 16 * 64 * tl + 31, 16, 1 << 30, true);
        const float nm = cl - mc;
#pragma unroll
        for (int r = 0; r < 16; ++r) { s0[r] = __builtin_amdgcn_exp2f(s0[r] + nm) * lc; s1[r] = __builtin_amdgcn_exp2f(s1[r] + nm) * lc; }
        {
            LAS float* imp = (LAS float*)(wsb + W_IMP) + ql * 64;
#pragma unroll
            for (int aa = 0; aa < 4; ++aa) {
                const int nb0 = 16 * tl + 2 * aa + C.hi, nb1 = nb0 + 8;
                const float g0 = (s0[4 * aa] + s0[4 * aa + 1]) + (s0[4 * aa + 2] + s0[4 * aa + 3]), g1 = (s1[4 * aa] + s1[4 * aa + 1]) + (s1[4 * aa + 2] + s1[4 * aa + 3]);
                (void)__hip_atomic_fetch_add(imp + nb0, g0, __ATOMIC_RELAXED, __HIP_MEMORY_SCOPE_WORKGROUP);
                (void)__hip_atomic_fetch_add(imp + nb1, g1, __ATOMIC_RELAXED, __HIP_MEMORY_SCOPE_WORKGROUP);
                if (nb0 + 1 < 64) (void)__hip_atomic_fetch_add(imp + nb0 + 1, s0[4 * aa + 3], __ATOMIC_RELAXED, __HIP_MEMORY_SCOPE_WORKGROUP);
                if (nb1 + 1 < 64) (void)__hip_atomic_fetch_add(imp + nb1 + 1, s1[4 * aa + 3], __ATOMIC_RELAXED, __HIP_MEMORY_SCOPE_WORKGROUP);
            }
        }
        pv(C, P.slot(), s0, s1, a.o);
        P.end_step();
    }
    a.l = 0.5f;
    fold(C, a, 0, out);
    unsigned long long mymask = 0ull, anymask = 0ull;
    {
        const LAS float* imp = (const LAS float*)(wsb + W_IMP);
        const int n = lane; const bool forced = (n == 0) || (n == qt) || (n == qt - 1), val = n <= qt;
#pragma unroll 1
        for (int q8 = 0; q8 < 8; ++q8) {
            const float score = forced ? 1e9f : (val ? imp[q8 * 64 + n] : -1e9f);
            int rank = 0;
#pragma unroll 8
            for (int m = 0; m < 64; ++m) { const float sm = __uint_as_float(__builtin_amdgcn_readlane(__float_as_uint(score), m)); rank += (sm > score || (sm == score && m < n)) ? 1 : 0; }
            const unsigned long long sel = __ballot(rank < 16 && val);
            anymask |= sel; if (ql == q8) mymask = sel;
        }
    }
    const bool trail = wid >= 4;
#pragma unroll 1
    for (int ph = 0; ph < 2; ++ph) {
        acc_zero(a);
        const int j0 = ph ? (qt > 8 ? qt - 8 : 0) : 0, nj = qt - j0 + 1, maxd = ph ? 511 : (1 << 30);
        bool pend = false; int pslot = 0; v4u pwp[4];
#pragma unroll
        for (int k = 0; k < 4; ++k) pwp[k] = (v4u){0u, 0u, 0u, 0u};
#pragma unroll 1
        for (int i = 0; i < nj; ++i) {
            const int j = j0 + i;
            P.begin_step(C);
            if (pend) { pv_packed(C, pslot, pwp, a.o); pend = false; }
            const bool wave_on = ph ? true : ((anymask >> j) & 1ull) != 0ull;
            if (wave_on) {
                const bool colsel = ph ? true : ((mymask >> j) & 1ull) != 0ull;
                scores(C, P.slot(), s0, s1);
                const bool far = (j <= qt - 3) && !(ph && j == qt - 8);
                float cl = 0.f;
                if (far) cl = colsel ? lut31 : MASKED; else bias_near(C, s0, s1, 64 * j, 1, maxd, colsel);
                softmax_step(C, a, s0, s1, cl);
                if (trail) { pack_p(s0, s1, pwp); pslot = P.slot(); pend = true; }
                else pv(C, P.slot(), s0, s1, a.o);
            }
            P.end_step();
        }
        if (pend) pv_packed(C, pslot, pwp, a.o);
        fold(C, a, 1 + ph, out);
    }
    {
        bf16* stg = (bf16*)(wsb + W_OST);
#pragma unroll
        for (int r = 0; r < 16; ++r) { const int c = crow(r, C.hi);
            stg[c * 64 + C.r32] = (bf16)(pk2(out[0][r], 0.f) & 0xffffu); stg[c * 64 + 32 + C.r32] = (bf16)(pk2(out[1][r], 0.f) & 0xffffu); }
        asm volatile("s_waitcnt lgkmcnt(0)" ::: "memory");
#pragma unroll
        for (int i = 0; i < 4; ++i) { const int c = i * 8 + (lane >> 3), ch = lane & 7;
            const v4u v = *(const LAS v4u*)(stg + c * 64 + ch * 8);
            *(v4u*)(O + ((size_t)b * 4096 + t0 + 8 * wid + (c >> 2)) * 512 + (g * 4 + (c & 3)) * 64 + ch * 8) = v; }
        asm volatile("s_waitcnt lgkmcnt(0)" ::: "memory");
    }
}
}

__device__ __forceinline__ void p4_attention(Frame& F, const Args& A) {
    unsigned char* ws = F.ws;
    LAS unsigned char* lds = F.lds + RING_OFF;
    { LAS float* lut = (LAS float*)(lds + att2::L_LUT); for (int e = F.tid; e < 1024; e += 512) lut[e] = ((const float*)(ws + WS_SMALL + SM_LUT))[e] * 1.4426950408889634f; }
    __syncthreads();
    const bf16* Q = (const bf16*)(ws + WS_Q); const bf16* KV = (const bf16*)(ws + WS_KV); const bf16* KC = (const bf16*)(ws + WS_KC); const bf16* GT = (const bf16*)(ws + WS_G);
    bf16* O = (bf16*)(ws + WS_O);
#ifndef PROBE_ATTN_REPS
#define PROBE_ATTN_REPS 1
#endif
    for (int ww = F.vcu; ww < 256 * PROBE_ATTN_REPS; ww += F.G) {
        const int w = ww & 255; const int bg = w >> 4, b = bg >> 1, g = bg & 1;
        att2::Ctx C; C.lds = lds; C.wid = F.wave; C.lane = F.lane; C.r32 = F.lane & 31; C.hi = F.lane >> 5;
        att2::Pipe P; P.init(KV, KC, w); P.prologue(C);
#pragma unroll 1
        for (int k = 0; k < 4; ++k) att2::unit(C, P, b, g, P.qt_of(k), Q, GT, O);
        asm volatile("s_waitcnt vmcnt(0) lgkmcnt(0)" ::: "memory"); __builtin_amdgcn_s_barrier(); asm volatile("" ::: "memory");
    }
}

__device__ __forceinline__ void p8_ln(Frame& F, const Args& A) {
    unsigned char* ws = F.ws; const int lane = F.lane;
    float* H1 = (float*)(ws + WS_H1); bf16* H1B = (bf16*)(ws + WS_H1B); bf16* HLO = (bf16*)(ws + WS_HLO);
    const int gw = F.vcu * NWAVES + F.wave, NGW = F.G * NWAVES;
    f32x4 gam[4], bet[4];
#pragma unroll
    for (int j = 0; j < 4; ++j) { gam[j] = ((const f32x4*)A.in[I_LN1G])[lane + 64 * j]; bet[j] = ((const f32x4*)A.in[I_LN1B])[lane + 64 * j]; }
#pragma unroll 2
    for (int m = gw; m < NTOK; m += NGW) {
        f32x4* xr = (f32x4*)(H1 + (size_t)m * DM) + lane; f32x4 h[4]; float s = 0.f;
#pragma unroll
        for (int j = 0; j < 4; ++j) { h[j] = xr[64 * j]; s += (h[j].x + h[j].y) + (h[j].z + h[j].w); }
        const float mean = wave_sum(s) * (1.f / DM); float s2 = 0.f;
#pragma unroll
        for (int j = 0; j < 4; ++j) { h[j] = h[j] - mean; s2 += (h[j].x * h[j].x + h[j].y * h[j].y) + (h[j].z * h[j].z + h[j].w * h[j].w); }
        const float rstd = 1.0f / sqrtf(wave_sum(s2) * (1.f / DM) + LN_EPS);
        v2u* o8 = (v2u*)(H1B + (size_t)m * DM) + lane; v2u* l8 = (v2u*)(HLO + (size_t)m * DM) + lane;
#pragma unroll
        for (int j = 0; j < 4; ++j) { h[j] = h[j] * rstd * gam[j] + bet[j]; xr[64 * j] = h[j];
            v2u w; w.x = pk2(h[j].x, h[j].y); w.y = pk2(h[j].z, h[j].w); o8[64 * j] = w;
            v2u q; q.x = pk2(h[j].x - bflo(w.x), h[j].y - bfhi(w.x)); q.y = pk2(h[j].z - bflo(w.y), h[j].w - bfhi(w.y)); l8[64 * j] = q; }
    }
}
template <class P> __device__ __forceinline__ int moe_tables(Frame& F, P cnt, LAS int* pstart  , LAS unsigned char* tile_e  ) {
    LAS int* nt = (LAS int*)(pstart + 64);
    if (F.tid == 0) { int acc = 0;
        for (int e = 0; e < 64; ++e) { const int c = (int)cnt[e]; const int tiles = (c + 255) >> 8; pstart[e] = acc * 256;
            for (int k = 0; k < tiles; ++k) tile_e[acc + k] = (unsigned char)e; acc += tiles; }
        nt[0] = acc; }
    __syncthreads();
    return nt[0];
}
__device__ __forceinline__ void p9_scatter(Frame& F, const Args& A) {
    unsigned char* ws = F.ws; const int lane = F.lane;
    LAS int* pstart = (LAS int*)(F.lds + LTAB_OFF); LAS unsigned char* tile_e = (LAS unsigned char*)(F.lds + LTAB_OFF + 512);
    LAS int* pre = (LAS int*)(F.lds + RING_OFF);
    LAS int* tot = pre + 128 * 64;
    const int* HIST = (const int*)(ws + WS_HIST);
    if (F.tid < 64) { int acc = 0;
#pragma unroll 8
        for (int w = 0; w < 128; ++w) { pre[w * 64 + F.tid] = acc; acc += HIST[w * 64 + F.tid]; }
        tot[F.tid] = acc; if (F.vcu == 0) ((int*)F.ctl)[CW_CNT + F.tid] = acc; }
    __syncthreads();
    (void)moe_tables(F, tot, pstart, tile_e);
    const bf16* H1B = (const bf16*)(ws + WS_H1B); bf16* XS = (bf16*)(ws + WS_XS); int* ROUTE = (int*)(ws + WS_ROUTE);
    const int gw = F.vcu * NWAVES + F.wave, NGW = F.G * NWAVES;
#pragma unroll 1
    for (int t0 = gw * 16; t0 < NTOK; t0 += NGW * 16) {
        int p1 = 0, p2 = 0;
        if (lane < 16) { int* rt = ROUTE + (size_t)(t0 + lane) * 8; const int e1 = rt[0], e2 = rt[1], w = (t0 + lane) >> 8;
            p1 = pstart[e1] + pre[w * 64 + e1] + rt[4]; p2 = pstart[e2] + pre[w * 64 + e2] + rt[5]; rt[6] = p1; rt[7] = p2; }
#pragma unroll 4
        for (int k = 0; k < 16; ++k) {
            const int q1 = __shfl(p1, k), q2 = __shfl(p2, k);
            const v4u* src = (const v4u*)(H1B + (size_t)(t0 + k) * DM) + lane; const v4u a = src[0], b = src[64];
            v4u* d1 = (v4u*)(XS + (size_t)q1 * DM) + lane; v4u* d2 = (v4u*)(XS + (size_t)q2 * DM) + lane;
            d1[0] = a; d1[64] = b; d2[0] = a; d2[64] = b;
        }
    }
}
__device__ __forceinline__ void p12_final(Frame& F, const Args& A, float* out) {
    unsigned char* ws = F.ws; const int lane = F.lane;
    const float* H1 = (const float*)(ws + WS_H1); const bf16* Y2 = (const bf16*)(ws + WS_Y2); const int* ROUTE = (const int*)(ws + WS_ROUTE);
    const int gw = F.vcu * NWAVES + F.wave, NGW = F.G * NWAVES;
    f32x4 gam[4], bet[4];
#pragma unroll
    for (int j = 0; j < 4; ++j) { gam[j] = ((const f32x4*)A.in[I_LN2G])[lane + 64 * j]; bet[j] = ((const f32x4*)A.in[I_LN2B])[lane + 64 * j]; }
    for (int m = gw; m < NTOK; m += NGW) {
        const int* rt = ROUTE + (size_t)m * 8; const float w1 = __int_as_float(rt[2]), w2 = __int_as_float(rt[3]); const int p1 = rt[6], p2 = rt[7];
        const f32x4* xr = (const f32x4*)(H1 + (size_t)m * DM) + lane; const v2u* y1 = (const v2u*)(Y2 + (size_t)p1 * DM) + lane; const v2u* y2 = (const v2u*)(Y2 + (size_t)p2 * DM) + lane;
        f32x4 v[4]; float s = 0.f;
#pragma unroll
        for (int j = 0; j < 4; ++j) { const f32x4 x = xr[64 * j]; const v2u a = y1[64 * j], b = y2[64 * j];
            v[j].x = x.x * DN_ALPHA + (w1 * bflo(a.x) + w2 * bflo(b.x)); v[j].y = x.y * DN_ALPHA + (w1 * bfhi(a.x) + w2 * bfhi(b.x));
            v[j].z = x.z * DN_ALPHA + (w1 * bflo(a.y) + w2 * bflo(b.y)); v[j].w = x.w * DN_ALPHA + (w1 * bfhi(a.y) + w2 * bfhi(b.y));
            s += (v[j].x + v[j].y) + (v[j].z + v[j].w); }
        const float mean = wave_sum(s) * (1.f / DM); float s2 = 0.f;
#pragma unroll
        for (int j = 0; j < 4; ++j) { v[j] = v[j] - mean; s2 += (v[j].x * v[j].x + v[j].y * v[j].y) + (v[j].z * v[j].z + v[j].w * v[j].w); }
        const float rstd = 1.0f / sqrtf(wave_sum(s2) * (1.f / DM) + LN_EPS);
        f32x4* o = (f32x4*)(out + (size_t)m * DM) + lane;
#pragma unroll
        for (int j = 0; j < 4; ++j) o[64 * j] = v[j] * rstd * gam[j] + bet[j];
    }
}

__global__ void __launch_bounds__(NWAVES * 64, 2) fwd(Args args) {
    extern __shared__ __attribute__((aligned(16))) unsigned char lds[];
    Frame F;
    F.lds = (LAS unsigned char*)lds;
    F.MISC = (volatile LAS unsigned*)(F.lds + MISC_OFF);
    F.tid = threadIdx.x; F.lane = F.tid & 63; F.wave = __builtin_amdgcn_readfirstlane(F.tid >> 6);
    F.G = gridDim.x; { const int bx = blockIdx.x; F.vcu = (F.G % 8 == 0) ? (bx % 8) * (F.G / 8) + bx / 8 : bx; }
    F.ws = args.ws; F.ctl = (gu32*)(args.ws + WS_CTL); F.in = nullptr;
    unsigned char* ws = args.ws;
    for (int u = F.tid; u < (LDS_BYTES - LDSCTL_OFF) / 4; u += NWAVES * 64) ((LAS unsigned*)(F.lds + LDSCTL_OFF))[u] = 0u;
    __syncthreads();
    XcdBarrier bar; bar.bar = (unsigned*)(F.ctl + CW_BAR); bar.x = 0; bar.st = nullptr;
    if (MK_N_LAUNCHES == 1) bar = xcd_barrier_post((unsigned*)(F.ctl + CW_BAR), F.MISC + 8);
#define GRID_BAR() do { if (MK_N_LAUNCHES == 1) xcd_barrier(bar); } while (0)
    const int lo = args.ph_lo, hi = args.ph_hi;
#ifndef PH_MASK
#define PH_MASK 0x1fff
#endif
#define IN(k) ((((PH_MASK) >> (k)) & 1) && lo <= (k) && (k) < hi)
#define BOTH(k) (IN(k) && IN((k) + 1))
#ifndef PROBE_REP_MASK
#define PROBE_REP_MASK 0
#endif
#define REPS(k) for (int rep_ = 0; rep_ < 1 + (((PROBE_REP_MASK) >> (k)) & 1); ++rep_)
    LAS unsigned char* ring = F.lds + RING_OFF;

    if (IN(0)) { _Pragma("unroll") REPS(0) { p0_prologue(F, args); __syncthreads(); } if (BOTH(0)) GRID_BAR(); }
    if (IN(1)) {
        pg8::Gemm g{(const bf16*)(ws + WS_XB), (const bf16*)(ws + WS_WINT), 1024, 1024, 1024}; pg8::StaticOrder S; S.init(NTOK, NPROJ, F.G, (int)blockIdx.x);
        EpiProj E{(bf16*)(ws + WS_Q), (bf16*)(ws + WS_KV), (bf16*)(ws + WS_SA), (bf16*)(ws + WS_MG), (bf16*)(ws + WS_G), (const float*)(ws + WS_SMALL + SM_BIASR)};
        _Pragma("unroll") REPS(1) { pg8::gemm_phase<EpiProj, pg8::StaticOrder, true, true>(ring, g, S, E); }
        if (BOTH(1)) GRID_BAR();
    }
    if (IN(2)) {
        REPS(2) {
        if (F.vcu < 32) { pg8::Gemm g{(const bf16*)(ws + WS_KV), (const bf16*)(ws + WS_W1CT), 1024, 2048, 2048}; ListOrder S{32, F.G, F.vcu, 1, 16};
          EpiF32Half<true> E{(float*)(ws + WS_HID), (const float*)(ws + WS_SMALL + SM_B1C)};
          pg8::gemm_phase<EpiF32Half<true>, ListOrder, true, true>(ring, g, S, E); }
        else expert_transposes(F, args, 32);
        { pg8::Gemm g{(const bf16*)(ws + WS_SA) + 128, (const bf16*)(ws + WS_BPT), 384, 256, 256}; ListOrder S{256, F.G, F.vcu, 1, 8};
          EpiF32Half<false> E{(float*)(ws + WS_E), nullptr};
          pg8::gemm_phase<EpiF32Half<false>, ListOrder, true, true>(ring, g, S, E); }
        }
        if (BOTH(2)) GRID_BAR();
    }
    if (IN(3)) { _Pragma("unroll") REPS(3) { p3_thin(F, args); } if (BOTH(3)) GRID_BAR(); }
    if (IN(4)) {
        REPS(4) {
        { int k384 = 384; asm volatile("" : "+s"(k384));
          pg8::Gemm g{(const bf16*)(ws + WS_SA), (const bf16*)(ws + WS_CT), 384, 384, k384}; ListOrder S{256, F.G, F.vcu, 1, 8};
          EpiS5Y E{(bf16*)(ws + WS_Z)};
          pg8::gemm_phase<EpiS5Y, ListOrder, true, true>(ring, g, S, E); }
        __syncthreads();
        p4_attention(F, args);
        __syncthreads(); }
        if (BOTH(4)) GRID_BAR();
    }
    if (IN(5)) {
        pg8::Gemm g{(const bf16*)(ws + WS_O), (const bf16*)(ws + WS_WAT), 512, 512, 512}; pg8::StaticOrder S; S.init(NTOK, 1024, F.G, (int)blockIdx.x);
        EpiYa E{(bf16*)(ws + WS_T), (const bf16*)(ws + WS_MG)};
        _Pragma("unroll") REPS(5) { pg8::gemm_phase<EpiYa, pg8::StaticOrder, true, true>(ring, g, S, E); }
        if (BOTH(5)) GRID_BAR();
    }
    if (IN(6)) {
        pg8::Gemm g{(const bf16*)(ws + WS_Z), (const bf16*)(ws + WS_WVGT), 512, 512, 512}; pg8::StaticOrder S; S.init(NTOK, 2048, F.G, (int)blockIdx.x);
        EpiYb E{(const bf16*)(ws + WS_T), (const bf16*)(ws + WS_MG), args.in[I_BGATE], (bf16*)(ws + WS_MIX)};
        REPS(6) { pg8::gemm_phase<EpiYb, pg8::StaticOrder, true, true>(ring, g, S, E); }
        if (BOTH(6)) GRID_BAR();
    }
    if (IN(7)) {
        pg8::Gemm g{(const bf16*)(ws + WS_MIX), (const bf16*)(ws + WS_WOT), 1024, 1024, 1024}; pg8::StaticOrder S; S.init(NTOK, 1024, F.G, (int)blockIdx.x);
        EpiOut E{args.in[I_X], (float*)(ws + WS_H1)};
        _Pragma("unroll") REPS(7) { pg8::gemm_phase<EpiOut, pg8::StaticOrder, true, true>(ring, g, S, E); }
        if (BOTH(7)) GRID_BAR();
    }
    if (IN(8)) {
        p8_ln(F, args);
        GRID_BAR();
        { pg8::Gemm g{(const bf16*)(ws + WS_H1B), (const bf16*)(ws + WS_WRT), 1024, 1024, 1024}; RouterOrder S{F.vcu};
          EpiRouter E{args.in[I_RBG], args.in[I_RBE], (int*)(ws + WS_ROUTE), (int*)(ws + WS_HIST)};
          REPS(8) { pg8::gemm_phase<EpiRouter, RouterOrder, false, true, true>(ring, g, S, E); } }
        if (BOTH(8)) GRID_BAR();
    }
    if (IN(9)) { REPS(9) { p9_scatter(F, args); __syncthreads(); } if (BOTH(9)) GRID_BAR(); }
    if (IN(10)) {
        LAS int* pstart = (LAS int*)(F.lds + LTAB_OFF); LAS unsigned char* tile_e = (LAS unsigned char*)(F.lds + LTAB_OFF + 512);
        const int ntiles = moe_tables(F, (const int*)F.ctl + CW_CNT, pstart, tile_e);
        pg8::Gemm g{(const bf16*)(ws + WS_XS), (const bf16*)(ws + WS_WGUT), 1024, 1024, 1024}; MoeOrder S{ntiles * 2, F.G, F.vcu, 2, tile_e};
        EpiMoe1 E{(bf16*)(ws + WS_HB)};
        _Pragma("unroll") REPS(10) { pg8::gemm_phase<EpiMoe1, MoeOrder, true, true>(ring, g, S, E); }
        if (BOTH(10)) GRID_BAR();
    }
    if (IN(11)) {
        LAS int* pstart = (LAS int*)(F.lds + LTAB_OFF); LAS unsigned char* tile_e = (LAS unsigned char*)(F.lds + LTAB_OFF + 512);
        const int ntiles = moe_tables(F, (const int*)F.ctl + CW_CNT, pstart, tile_e);
        int k256 = 256; asm volatile("" : "+s"(k256));
        pg8::Gemm g{(const bf16*)(ws + WS_HB), (const bf16*)(ws + WS_WDT), 256, 256, k256}; MoeOrder S{ntiles * 4, F.G, F.vcu, 4, tile_e};
        EpiMoe2 E{(bf16*)(ws + WS_Y2)};
        _Pragma("unroll") REPS(11) { pg8::gemm_phase<EpiMoe2, MoeOrder, true, true>(ring, g, S, E); }
        if (BOTH(11)) GRID_BAR();
    }
#ifdef PROBE_EXTRA_BARS
    if (IN(12)) { _Pragma("unroll 1") for (int xb = 0; xb < PROBE_EXTRA_BARS; ++xb) GRID_BAR(); }
#endif
    if (IN(12)) { _Pragma("unroll") REPS(12) { p12_final(F, args, args.out); } }
#undef IN
#undef BOTH
}

extern "C" void kernel_launch(void* const* d_in, const int* in_sizes, int n_in, void* d_out, int out_size, void* d_ws, size_t ws_size, hipStream_t stream) {
    static int grid = 0;
    if (grid == 0) {
        if (n_in != 33 || out_size != NTOK * DM || ws_size < WS_END) { fprintf(stderr, "kernel_launch: unexpected problem shape (n_in %d, out %d, ws %zu)\n", n_in, out_size, ws_size); grid = -1; return; }
        int dev = 0, cus = 0, per_cu = 0;
        if (hipGetDevice(&dev) != hipSuccess || hipDeviceGetAttribute(&cus, hipDeviceAttributeMultiprocessorCount, dev) != hipSuccess) { grid = -1; return; }
        if (hipFuncSetAttribute((const void*)fwd, hipFuncAttributeMaxDynamicSharedMemorySize, LDS_BYTES) != hipSuccess) { fprintf(stderr, "kernel_launch: hipFuncSetAttribute failed\n"); grid = -1; return; }
        if (hipOccupancyMaxActiveBlocksPerMultiprocessor(&per_cu, (const void*)fwd, NWAVES * 64, LDS_BYTES) != hipSuccess || per_cu < 1)
            fprintf(stderr, "kernel_launch: occupancy query reports %d workgroups per CU\n", per_cu);
        (void)hipGetLastError();
        grid = cus;
    }
    if (grid < 0) return;
    if (hipMemsetAsync((char*)d_ws + WS_CTL, 0, CTL_ZERO_BYTES, stream) != hipSuccess) return;
    Args a{};
    for (int i = 0; i < 33; ++i) a.in[i] = (const float*)d_in[i];
    a.out = (float*)d_out; a.ws = (unsigned char*)d_ws;
    if (MK_N_LAUNCHES == 1) { a.ph_lo = 0; a.ph_hi = N_PHASES; hipLaunchKernelGGL(fwd, dim3(grid), dim3(NWAVES * 64), LDS_BYTES, stream, a); }
    else for (int li = 0; li < N_PHASES; ++li) { a.ph_lo = li; a.ph_hi = li + 1; hipLaunchKernelGGL(fwd, dim3(grid), dim3(NWAVES * 64), LDS_BYTES, stream, a); }
}
```

```cpp
#include <hip/hip_runtime.h>
#include <cstdio>
#include <cstdint>
#include <cmath>
namespace pg8 {
#define PG8_LAS __attribute__((address_space(3)))
typedef unsigned short bf16_t;
typedef short bf16x8 __attribute__((ext_vector_type(8)));
typedef float f32x4 __attribute__((ext_vector_type(4)));
typedef unsigned u32x4 __attribute__((ext_vector_type(4)));
constexpr int BM = 256, BK = 64, HALF = 128, HTB = HALF * BK * 2  , STAGE_BYTES = 8 * HTB, NXCD = 8, WGM = 8;

__host__ __device__ __forceinline__ int lds_byte(int r, int c) { const int st = (r >> 4) * 2 + (c >> 5), rr = r & 15, cc = c & 31, ob = rr * 64 + cc * 2; return st * 1024 + (ob ^ (((ob >> 9) & 1) << 5)); }
__host__ __device__ __forceinline__ void stage_rc(int b, int& R, int& C) { const int st = b / 1024, sb = b % 1024, swz = sb ^ (((sb >> 9) & 1) << 5); R = (st >> 1) * 16 + swz / 64; C = (st & 1) * 32 + (swz % 64) / 2; }
__host__ __device__ __forceinline__ int perm32(int rho) { const int n = rho >> 4, i = rho & 15; return 8 * (i >> 2) + 4 * n + (i & 3); }

struct Unit { int pm, pn; };
struct Gemm { const bf16_t* A; const bf16_t* Bt; int lda, ldb, K; };

struct StaticOrder {
    int nM, nN, nwg, G, c;
    __host__ __device__ void init(int M, int N, int G_, int c_) { nM = M / BM; nN = N / BM; nwg = nM * nN; G = G_; c = c_; }
    __host__ __device__ bool next(int i, Unit& u) const {
        const long L = (long)i * G + c; if (L >= nwg) return false;
        int wgid = (int)L; { const int q = nwg / NXCD, r = nwg % NXCD, xcd = wgid % NXCD, off = wgid / NXCD; wgid = (xcd < r ? xcd * (q + 1) : r * (q + 1) + (xcd - r) * q) + off; }
        const int nig = WGM * nN, gid = wgid / nig, fm = gid * WGM, gsz = (nM - fm) < WGM ? (nM - fm) : WGM;
        u.pm = fm + ((wgid % nig) % gsz); u.pn = (wgid % nig) / gsz; return true;
    }
    __device__ __forceinline__ void a_ready(const Unit&) const {}
    __device__ __forceinline__ void done(const Unit&) const {}
};

__device__ __forceinline__ unsigned cvt_pk_bf16(float lo, float hi) { unsigned r; asm volatile("v_cvt_pk_bf16_f32 %0, %1, %2" : "=v"(r) : "v"(lo), "v"(hi)); return r; }

template <class Epi, class Sched, bool ALIGN_EPI = false, bool SP2 = false, bool KEEP_ACC = false>
__device__ __forceinline__ void gemm_phase(PG8_LAS unsigned char* lds, const Gemm g, const Sched& S, const Epi& E) {
    const int tid = threadIdx.x, wid = __builtin_amdgcn_readfirstlane(tid >> 6), lane = tid & 63, wr = wid >> 2, wc = wid & 3, fr = lane & 15, fq = lane >> 4;
    const int K = g.K, nt = K / BK;
    unsigned voffA[2], voffB[2];
#pragma unroll
    for (int i = 0; i < 2; ++i) { int R, C; stage_rc(tid * 16 + i * 8192, R, C); const int Rb = Epi::PERM ? ((R & ~31) + perm32(R & 31)) : R;
        voffA[i] = (unsigned)(R * g.lda + C) * 2u; voffB[i] = (unsigned)(Rb * g.ldb + C) * 2u; }
    const size_t kstep = (size_t)(BK * 2);
    const size_t hstepA = (size_t)HALF * g.lda * 2, hstepB = (size_t)HALF * g.ldb * 2;
    const size_t tstepA = 2 * hstepA, tstepB = 2 * hstepB;
    const unsigned ldsw = (unsigned)wid * 1024u;
    const int aoff = lds_byte(wr * 64 + fr, fq * 8), boff = lds_byte(wc * 32 + fr, fq * 8);
#define PG8_SA(b, h) (((b) * 2 + (h)) * HTB)
#define PG8_SB(b, h) ((4 + (b) * 2 + (h)) * HTB)
#define PG8_STAGE(bufoff, gbase, voff) do { _Pragma("unroll") for (int _i = 0; _i < 2; ++_i) \
        __builtin_amdgcn_global_load_lds((const unsigned*)((const char*)(gbase) + (voff)[_i]), (PG8_LAS unsigned*)(lds + (bufoff) + ldsw + _i * 8192), 16, 0, 0); } while (0)
#define PG8_LDA(dst, b, h) do { _Pragma("unroll") for (int m = 0; m < 4; ++m) _Pragma("unroll") for (int k = 0; k < 2; ++k) dst[m][k] = *(const PG8_LAS bf16x8*)(lds + PG8_SA(b, h) + aoff + m * 2048 + k * 1024); } while (0)
#define PG8_LDB(dst, b, h) do { _Pragma("unroll") for (int n = 0; n < 2; ++n) _Pragma("unroll") for (int k = 0; k < 2; ++k) dst[n][k] = *(const PG8_LAS bf16x8*)(lds + PG8_SB(b, h) + boff + n * 2048 + k * 1024); } while (0)
#define PG8_MMA(ai, bj, At, Bt) do { __builtin_amdgcn_s_setprio(1); _Pragma("unroll") for (int m = 0; m < 4; ++m) _Pragma("unroll") for (int n = 0; n < 2; ++n) _Pragma("unroll") for (int k = 0; k < 2; ++k) \
        acc[ai][bj][m][n] = __builtin_amdgcn_mfma_f32_16x16x32_bf16(Bt[n][k], At[m][k], acc[ai][bj][m][n], 0, 0, 0); __builtin_amdgcn_s_setprio(0); } while (0)
#define PG8_WAIT_V(n) asm volatile("s_waitcnt vmcnt(" #n ")" ::: "memory")
#define PG8_WAIT_L(n) asm volatile("s_waitcnt lgkmcnt(" #n ")" ::: "memory")
#define PG8_BAR __builtin_amdgcn_s_barrier()
#define PG8_SCHED __builtin_amdgcn_sched_barrier(0)
    Unit cur, nxt; int ui = 0;
    if (!S.next(0, cur)) return;
    f32x4 acc[2][2][4][2];
#pragma unroll
    for (int a = 0; a < 2; ++a)
#pragma unroll
        for (int b = 0; b < 2; ++b)
#pragma unroll
            for (int m = 0; m < 4; ++m)
#pragma unroll
                for (int n = 0; n < 2; ++n) acc[a][b][m][n] = (f32x4){0.f, 0.f, 0.f, 0.f};
    bf16x8 At[4][2], B0[2][2], B1[2][2];
    const char* cA = (const char*)g.A + (size_t)cur.pm * tstepA; const char* cB = (const char*)g.Bt + (size_t)cur.pn * tstepB;
    S.a_ready(cur);
    if constexpr (SP2) {
        PG8_STAGE(PG8_SB(0, 0), cB, voffB); PG8_STAGE(PG8_SB(0, 1), cB + hstepB, voffB); PG8_STAGE(PG8_SA(0, 0), cA, voffA); PG8_STAGE(PG8_SA(0, 1), cA + hstepA, voffA);
        if (wr == 1) PG8_BAR;
        PG8_WAIT_V(2); PG8_BAR;
        PG8_STAGE(PG8_SB(1, 0), cB + kstep, voffB); PG8_STAGE(PG8_SA(1, 0), cA + kstep, voffA); PG8_STAGE(PG8_SB(1, 1), cB + hstepB + kstep, voffB);
        PG8_WAIT_V(6); PG8_BAR;
    } else {
        PG8_STAGE(PG8_SB(0, 0), cB, voffB); PG8_STAGE(PG8_SA(0, 0), cA, voffA); PG8_STAGE(PG8_SB(0, 1), cB + hstepB, voffB); PG8_STAGE(PG8_SA(0, 1), cA + hstepA, voffA);
        if (wr == 1) PG8_BAR;
        PG8_WAIT_V(4); PG8_BAR;
        PG8_STAGE(PG8_SB(1, 0), cB + kstep, voffB); PG8_STAGE(PG8_SA(1, 0), cA + kstep, voffA); PG8_STAGE(PG8_SB(1, 1), cB + hstepB + kstep, voffB);
        PG8_WAIT_V(6); PG8_BAR;
    }
    for (;;) {
        const bool has_next = S.next(ui + 1, nxt);
        const char* nA = has_next ? (const char*)g.A + (size_t)nxt.pm * tstepA : cA; const char* nB = has_next ? (const char*)g.Bt + (size_t)nxt.pn * tstepB : cB;
        for (int t = 0; t < nt; t += 2) {
            const bool last = (t == nt - 2);
            const char* a1 = cA + (size_t)(t + 1) * kstep;
            const char* a2 = last ? nA : cA + (size_t)(t + 2) * kstep; const char* b2 = last ? nB : cB + (size_t)(t + 2) * kstep;
            const char* a3 = a2 + kstep; const char* b3 = b2 + kstep;
            if (last && has_next) S.a_ready(nxt);
            if constexpr (SP2) {
            PG8_LDB(B0, 0, 0); PG8_LDB(B1, 0, 1); PG8_SCHED; PG8_LDA(At, 0, 0); PG8_STAGE(PG8_SA(1, 1), a1 + hstepA, voffA);
            PG8_WAIT_V(8); PG8_WAIT_L(0); PG8_BAR; PG8_MMA(0, 0, At, B0); PG8_MMA(0, 1, At, B1); PG8_BAR; PG8_SCHED;
            PG8_LDA(At, 0, 1); PG8_STAGE(PG8_SB(0, 0), b2, voffB); PG8_STAGE(PG8_SB(0, 1), b2 + hstepB, voffB); PG8_STAGE(PG8_SA(0, 0), a2, voffA);
            PG8_WAIT_V(8); PG8_WAIT_L(0); PG8_BAR; PG8_MMA(1, 0, At, B0); PG8_MMA(1, 1, At, B1); PG8_BAR; PG8_SCHED;
            PG8_LDB(B0, 1, 0); PG8_LDB(B1, 1, 1); PG8_SCHED; PG8_LDA(At, 1, 0); PG8_STAGE(PG8_SA(0, 1), a2 + hstepA, voffA);
            PG8_WAIT_V(8); PG8_WAIT_L(0); PG8_BAR; PG8_MMA(0, 0, At, B0); PG8_MMA(0, 1, At, B1); PG8_BAR; PG8_SCHED;
            PG8_LDA(At, 1, 1); PG8_STAGE(PG8_SB(1, 0), b3, voffB); PG8_STAGE(PG8_SB(1, 1), b3 + hstepB, voffB); PG8_STAGE(PG8_SA(1, 0), a3, voffA);
            PG8_WAIT_V(8); PG8_WAIT_L(0); PG8_BAR; PG8_MMA(1, 0, At, B0); PG8_MMA(1, 1, At, B1); PG8_BAR; PG8_SCHED;
            } else {
            PG8_LDB(B0, 0, 0); PG8_SCHED; PG8_LDA(At, 0, 0); PG8_STAGE(PG8_SA(1, 1), a1 + hstepA, voffA);
            PG8_WAIT_L(8); PG8_BAR; PG8_WAIT_L(0); PG8_MMA(0, 0, At, B0); PG8_BAR; PG8_SCHED;
            PG8_LDB(B1, 0, 1); PG8_STAGE(PG8_SB(0, 0), b2, voffB);
            PG8_BAR; PG8_WAIT_L(0); PG8_MMA(0, 1, At, B1); PG8_BAR;
            PG8_LDA(At, 0, 1); PG8_STAGE(PG8_SA(0, 0), a2, voffA);
            PG8_BAR; PG8_WAIT_L(0); PG8_MMA(1, 0, At, B0); PG8_BAR; PG8_SCHED;
            PG8_STAGE(PG8_SB(0, 1), b2 + hstepB, voffB);
            PG8_WAIT_V(6); PG8_BAR; PG8_MMA(1, 1, At, B1); PG8_BAR;
            PG8_LDB(B0, 1, 0); PG8_SCHED; PG8_LDA(At, 1, 0); PG8_STAGE(PG8_SA(0, 1), a2 + hstepA, voffA);
            PG8_WAIT_L(8); PG8_BAR; PG8_WAIT_L(0); PG8_MMA(0, 0, At, B0); PG8_BAR; PG8_SCHED;
            PG8_LDB(B1, 1, 1); PG8_STAGE(PG8_SB(1, 0), b3, voffB);
            PG8_BAR; PG8_WAIT_L(0); PG8_MMA(0, 1, At, B1); PG8_BAR;
            PG8_LDA(At, 1, 1); PG8_STAGE(PG8_SA(1, 0), a3, voffA);
            PG8_BAR; PG8_WAIT_L(0); PG8_MMA(1, 0, At, B0); PG8_BAR; PG8_SCHED;
            PG8_STAGE(PG8_SB(1, 1), b3 + hstepB, voffB);
            PG8_WAIT_V(6); PG8_BAR; PG8_MMA(1, 1, At, B1); PG8_BAR;
            }
        }
        if constexpr (ALIGN_EPI) { if (wr == 0) PG8_BAR; }
        if constexpr (!Epi::AFTER_DRAIN) { E(acc, cur, wr, wc, fr, fq); S.done(cur); }
        if (!has_next) break;
        if constexpr (!KEEP_ACC) {
#pragma unroll
        for (int a = 0; a < 2; ++a)
#pragma unroll
            for (int b = 0; b < 2; ++b)
#pragma unroll
                for (int m = 0; m < 4; ++m)
#pragma unroll
                    for (int n = 0; n < 2; ++n) acc[a][b][m][n] = (f32x4){0.f, 0.f, 0.f, 0.f};
        }
        cur = nxt; cA = nA; cB = nB; ++ui;
        if constexpr (ALIGN_EPI) { if (wr == 1) PG8_BAR; }
    }
    PG8_WAIT_V(0);
    if constexpr (!ALIGN_EPI) { if (wr == 0) PG8_BAR; }
    PG8_BAR;
    if constexpr (Epi::AFTER_DRAIN) { E.fused(acc, cur, wr, wc, fr, fq, lds, wid, lane); S.done(cur); }
#undef PG8_SA
#undef PG8_SB
#undef PG8_STAGE
#undef PG8_LDA
#undef PG8_LDB
#undef PG8_MMA
#undef PG8_WAIT_V
#undef PG8_WAIT_L
#undef PG8_BAR
#undef PG8_SCHED
}
}

constexpr int NWAVES = 8;
#ifndef MK_N_LAUNCHES
#define MK_N_LAUNCHES 1
#endif
constexpr int N_PHASES = 13;
constexpr int DM = 1024, NB = 8, SEQ = 4096, NTOK = NB * SEQ;
constexpr int NPROJ = 4096;
constexpr int D_IN = 3864;
constexpr int MOE_CAP = 2 * NTOK + 64 * 256;
constexpr float LN_EPS = 1e-5f;
constexpr float DN_ALPHA = 1.189207115002721f;

constexpr size_t MiB = 1u << 20;
constexpr size_t WS_CTL = 0, CTL_ZERO_BYTES = 64 * 1024;
constexpr size_t WS_SMALL = 1 * MiB;
constexpr size_t WS_WAT = 2 * MiB, WS_WVGT = 3 * MiB, WS_WOT = 5 * MiB, WS_W1CT = 7 * MiB, WS_BPT = 9 * MiB, WS_CT = 13 * MiB;
constexpr size_t WS_ROUTE = 19 * MiB;
constexpr size_t WS_HIST = 1 * MiB + 128 * 1024;
constexpr size_t WS_KC = 20 * MiB;
constexpr size_t WS_HID = 21 * MiB;
constexpr size_t WS_WRT = 25 * MiB;
constexpr size_t WS_WGUT = 26 * MiB, WS_WDT = 90 * MiB;
constexpr size_t WS_MG = 122 * MiB;
constexpr size_t WS_H1 = WS_MG;
constexpr size_t WS_XB = 250 * MiB;
constexpr size_t WS_Z = 250 * MiB, WS_O = 282 * MiB, WS_H1B = 250 * MiB, WS_HB = 250 * MiB;
constexpr size_t WS_Q = 314 * MiB, WS_KV = 346 * MiB, WS_SA = 394 * MiB, WS_G = 442 * MiB, WS_WINT = 444 * MiB, WS_E = 452 * MiB;
constexpr size_t WS_HLO = 314 * MiB;
constexpr size_t WS_T = 314 * MiB;
constexpr size_t WS_MIX = 394 * MiB;
constexpr size_t WS_XS = 314 * MiB, WS_Y2 = 314 * MiB;
constexpr size_t WS_END = 512 * MiB;
static_assert(WS_XS + (size_t)MOE_CAP * 1024 * 2 <= WS_END && WS_HB + (size_t)MOE_CAP * 256 * 2 <= WS_XS, "d_ws map");
constexpr size_t SM_BIASR = 0;
constexpr size_t SM_B1C = 32 * 1024;
constexpr size_t SM_LUT = 40 * 1024;
constexpr size_t SM_A16 = 48 * 1024;
constexpr int CW_CNT = 64, CW_CUR = 128;
constexpr int CW_BAR = 4096;

constexpr int RING_OFF = 0, RING_BYTES = 131072;
constexpr int LDSCTL_OFF = RING_BYTES, MISC_OFF = LDSCTL_OFF + 320;
constexpr int LTAB_OFF = LDSCTL_OFF + 1024;
constexpr int LDS_BYTES = 147456;

#define GAS __attribute__((address_space(1)))
#define LAS __attribute__((address_space(3)))
typedef unsigned short bf16;
typedef unsigned v4u __attribute__((ext_vector_type(4)));
typedef unsigned v2u __attribute__((ext_vector_type(2)));
typedef float f32x4 __attribute__((ext_vector_type(4)));
typedef float f32x2 __attribute__((ext_vector_type(2)));
typedef GAS unsigned gu32;
#define RLX_AGENT __ATOMIC_RELAXED, __HIP_MEMORY_SCOPE_AGENT
#define LDS_WAIT() asm volatile("s_waitcnt lgkmcnt(0)" ::: "memory")
#define VM_WAIT() asm volatile("s_waitcnt vmcnt(0)" ::: "memory")
typedef __bf16 bf16x2_t __attribute__((ext_vector_type(2)));
__device__ __forceinline__ unsigned pk2(float lo, float hi) { const f32x2 v = {lo, hi}; const bf16x2_t b = __builtin_convertvector(v, bf16x2_t); return __builtin_bit_cast(unsigned, b); }
__device__ __forceinline__ float bflo(unsigned w) { return __uint_as_float(w << 16); }
__device__ __forceinline__ float bfhi(unsigned w) { return __uint_as_float(w & 0xffff0000u); }
__device__ __forceinline__ float bf2f(bf16 h) { return __uint_as_float(((unsigned)h) << 16); }
__device__ __forceinline__ float sigmoidf_(float x) { return __builtin_amdgcn_rcpf(1.0f + __expf(-x)); }
__device__ __forceinline__ float gelu_tanh(float x) { const float z2 = x * (1.5957691216057308f + 0.07135481627260025f * x * x); return x * __builtin_amdgcn_rcpf(1.0f + __expf(-z2)); }
__device__ __forceinline__ float wave_sum(float v) {
#pragma unroll
    for (int o = 1; o < 64; o <<= 1) v += __shfl_xor(v, o);
    return v;
}
__device__ __forceinline__ float wave_max(float v) {
#pragma unroll
    for (int o = 1; o < 64; o <<= 1) v = fmaxf(v, __shfl_xor(v, o));
    return v;
}

#define XB_TMO      128
#define XB_XCNT(j)  (256  + 64 * (j))
#define XB_XSUB(j)  (1280 + 64 * (j))
#define XB_XGEN(j)  (2304 + 64 * (j))
#define XB_TOP      3328
#define XB_TOPGEN   3392
#define XCD_BAR_WORDS 3456
#define XB_SPIN_CAP (1u << 18)

__device__ __forceinline__ unsigned xb_ld(unsigned* p)              { return __hip_atomic_load(p, __ATOMIC_RELAXED, __HIP_MEMORY_SCOPE_AGENT); }
__device__ __forceinline__ unsigned xb_add(unsigned* p, unsigned v) { return __hip_atomic_fetch_add(p, v, __ATOMIC_RELAXED, __HIP_MEMORY_SCOPE_AGENT); }
__device__ __forceinline__ unsigned xb_xcc_id() { return (unsigned)__builtin_amdgcn_s_getreg((3 << 11) | 20) & 0xFu; }
#define XB_SPIN(cond, bar) do { unsigned _sp = 0; while (cond) { __builtin_amdgcn_s_sleep(1); \
    if ((++_sp & 255u) == 0u) { if (xb_ld(&(bar)[XB_TMO])) break; if (_sp > XB_SPIN_CAP) { atomicAdd(&(bar)[XB_TMO], 1u); break; } } } } while (0)

struct XcdBarrier {
    unsigned* bar; unsigned x;
    volatile LAS unsigned* st;
};

__device__ __forceinline__ XcdBarrier xcd_barrier_post(unsigned* bar, volatile LAS unsigned* st) {
    XcdBarrier b; b.bar = bar; b.x = xb_xcc_id(); b.st = st;
    if (threadIdx.x == 0) (void)xb_add(&bar[XB_XCNT(b.x)], 1u);
    return b;
}
__device__ __forceinline__ void xcd_barrier_complete(unsigned* bar, unsigned x, unsigned& nloc, unsigned& nx) {
    const unsigned G = gridDim.x * gridDim.y * gridDim.z;
    unsigned sum, cnt, mine, sp = 0u;
    for (;;) {
        sum = 0u; cnt = 0u; mine = 0u;
#pragma unroll
        for (unsigned j = 0; j < 16; ++j) { const unsigned c = xb_ld(&bar[XB_XCNT(j)]); sum += c; cnt += (c > 0u) ? 1u : 0u; mine = (j == x) ? c : mine; }
        if (sum == G) break;
        __builtin_amdgcn_s_sleep(1);
        if ((++sp & 255u) == 0u) { if (xb_ld(&bar[XB_TMO])) break; if (sp > XB_SPIN_CAP) { atomicAdd(&bar[XB_TMO], 1u); break; } }
    }
    nloc = mine > 0u ? mine : 1u; nx = cnt > 0u ? cnt : 1u;
}

__device__ __forceinline__ void xcd_barrier(const XcdBarrier& b) {
    asm volatile("s_waitcnt vmcnt(0)" ::: "memory");
    __syncthreads();
    if (threadIdx.x == 0) {
        unsigned* bar = b.bar;
        __builtin_amdgcn_s_waitcnt(0);
        unsigned nloc = b.st[0], nx = b.st[1];
        if (nloc == 0u) { xcd_barrier_complete(bar, b.x, nloc, nx); b.st[0] = nloc; b.st[1] = nx; }
        const unsigned old = xb_add(&bar[XB_XSUB(b.x)], 1u);
        const unsigned gen = old / nloc;
        if (old + 1u == (gen + 1u) * nloc) {
            __builtin_amdgcn_fence(__ATOMIC_RELEASE, "agent");
            asm volatile("s_waitcnt vmcnt(0)" ::: "memory");
            const unsigned og = xb_add(&bar[XB_TOP], 1u);
            const unsigned tg = og / nx;
            if (og + 1u == (tg + 1u) * nx) xb_add(&bar[XB_TOPGEN], 1u);
            else XB_SPIN(xb_ld(&bar[XB_TOPGEN]) == tg, bar);
            __builtin_amdgcn_fence(__ATOMIC_ACQUIRE, "agent");
            xb_add(&bar[XB_XGEN(b.x)], 1u);
            asm volatile("s_waitcnt vmcnt(0)" ::: "memory");
        } else {
            XB_SPIN(xb_ld(&bar[XB_XGEN(b.x)]) == gen, bar);
            __builtin_amdgcn_fence(__ATOMIC_ACQUIRE, "agent");
            asm volatile("s_waitcnt vmcnt(0)" ::: "memory");
        }
    }
    __syncthreads();
}

struct Frame {
    LAS unsigned char* lds;
    volatile LAS unsigned* MISC;
    gu32* ctl;
    int tid, lane, wave, vcu, G;
    const float* const* in;
    unsigned char* ws;
};
struct Args { const float* in[33]; float* out; unsigned char* ws; int ph_lo, ph_hi; };
enum { I_X = 0, I_RELB, I_WIN, I_BIN, I_CPOS, I_CW1, I_CB1, I_CW2, I_CB2, I_WATT, I_LRE, I_LIM, I_LDT, I_BRE, I_BIM, I_CRE, I_CIM, I_SD, I_WVAL, I_WGATE, I_BGATE, I_WOUT,
       I_LN1G, I_LN1B, I_RWG, I_RBG, I_RWE, I_RBE, I_EWG, I_EWU, I_EWD, I_LN2G, I_LN2B };

struct TrItem { const float* colp; int ldw, k0, K; bf16* wt; };
__device__ __forceinline__ void tr_load(const TrItem& t, float (&tv)[32], int lane) {
#pragma unroll
    for (int i = 0; i < 32; ++i) { const int kk = 2 * i + (lane >> 5); tv[i] = t.colp ? t.colp[(size_t)(t.k0 + kk) * t.ldw] : 0.f; }
}
__device__ __forceinline__ void tr_store(const TrItem& t, const float (&tv)[32], LAS float* scr, int lane) {
#pragma unroll
    for (int i = 0; i < 32; ++i) { const int kk = 2 * i + (lane >> 5); scr[kk * 33 + (lane & 31)] = tv[i]; }
    LDS_WAIT(); asm volatile("" ::: "memory");
    const int c = lane & 7;
#pragma unroll
    for (int j = 0; j < 4; ++j) { const int n = (lane >> 3) + 8 * j; const LAS float* s = scr + (8 * c) * 33 + n;
        v4u o; o.x = pk2(s[0 * 33], s[1 * 33]); o.y = pk2(s[2 * 33], s[3 * 33]); o.z = pk2(s[4 * 33], s[5 * 33]); o.w = pk2(s[6 * 33], s[7 * 33]);
        *(v4u*)(t.wt + (size_t)n * t.K + 8 * c) = o; }
    LDS_WAIT(); asm volatile("" ::: "memory");
}
__device__ __forceinline__ void tr_item(const float* colp, int ldw, int k0, bf16* wt_row0  , int K, LAS float* scr, int lane) {
    const TrItem t{colp, ldw, k0, K, wt_row0}; float tv[32]; tr_load(t, tv, lane); tr_store(t, tv, scr, lane);
}
__device__ __forceinline__ int proj_src_col(int n) {
    return n < 1280 ? n : (n < 3840 ? n + 24 : (n < 3864 ? n - 3840 + 1280 : -1));
}
__device__ __forceinline__ int t5_bucket(int n) {
    if (n < 16) return n;
    const float nf = (float)n;
    int large = 16 + (int)(logf(nf / 16.0f) / 2.0794415416798357f * 16.0f);
    return large < 31 ? large : 31;
}
__device__ __forceinline__ void p0_prologue(Frame& F, const Args& A) {
    unsigned char* ws = F.ws;
    const int gw = F.vcu * NWAVES + F.wave, NGW = F.G * NWAVES, lane = F.lane;
    if (F.vcu < 32) {
        const int g = F.vcu, tid = F.tid;
        LAS float* pwr = (LAS float*)(F.lds);
        LAS float* pwi = pwr + 17 * 64;
        LAS float* bbr = pwi + 17 * 64;
        LAS float* bbi = bbr + 1024;
        LAS float* ccr = bbi + 1024;
        LAS float* cci = ccr + 1024;
        LAS float* kk  = cci + 1024;
        LAS float* fre = kk + 4096;
        if (tid < 64) {
            const int p = tid; const float lr = A.in[I_LRE][g * 64 + p], li = A.in[I_LIM][g * 64 + p], dt = expf(A.in[I_LDT][g]);
            for (int k = 0; k <= 16; ++k) { const float mag = expf((float)k * lr * dt), ang = (float)k * li * dt; pwr[k * 64 + p] = mag * cosf(ang); pwi[k * 64 + p] = mag * sinf(ang); }
            const float mag = expf(lr * dt), abr = mag * cosf(li * dt), abi = mag * sinf(li * dt), nr = abr - 1.0f, ni = abi, den = lr * lr + li * li;
            fre[p] = (nr * lr + ni * li) / den; fre[64 + p] = (ni * lr - nr * li) / den;
            float* a16 = (float*)(ws + WS_SMALL + SM_A16) + (size_t)(g * 64 + p) * 2; a16[0] = pwr[16 * 64 + p]; a16[1] = pwi[16 * 64 + p];
        }
        __syncthreads();
        for (int e = tid; e < 1024; e += 512) { const int p = e >> 4; const float br = A.in[I_BRE][g * 1024 + e], bi = A.in[I_BIM][g * 1024 + e], fr = fre[p], fi = fre[64 + p];
            bbr[e] = fr * br - fi * bi; bbi[e] = fr * bi + fi * br; ccr[e] = A.in[I_CRE][g * 1024 + e]; cci[e] = A.in[I_CIM][g * 1024 + e]; }
        __syncthreads();
        for (int e = tid; e < 4096; e += 512) { const int d = e >> 8, h = (e >> 4) & 15, h2 = e & 15; float s = 0.f;
            for (int p = 0; p < 64; ++p) { const float cr = ccr[h * 64 + p], ci = cci[h * 64 + p], ar = pwr[d * 64 + p], ai = pwi[d * 64 + p], br = bbr[p * 16 + h2], bi = bbi[p * 16 + h2];
                const float tr = cr * ar - ci * ai, ti = cr * ai + ci * ar; s += tr * br - ti * bi; }
            if (d == 0 && h == h2) s += A.in[I_SD][g * 16 + h];
            kk[e] = s; }
        __syncthreads();
        bf16* CT = (bf16*)(ws + WS_CT) + (size_t)g * 256 * 384;
        for (int v = tid; v < 256 * 48; v += 512) { const int n = v / 48, k0 = (v % 48) * 8, tau = n >> 4, h = n & 15; float o[8];
#pragma unroll
            for (int i = 0; i < 8; ++i) { const int k = k0 + i;
                if (k < 128) { const int p = k & 63; const float cr = ccr[h * 64 + p], ci = cci[h * 64 + p], ar = pwr[(tau + 1) * 64 + p], ai = pwi[(tau + 1) * 64 + p];
                    o[i] = (k < 64) ? (cr * ar - ci * ai) : -(cr * ai + ci * ar); }
                else { const int s = (k - 128) >> 4, h2 = (k - 128) & 15; o[i] = (s <= tau) ? kk[((tau - s) << 8) + (h << 4) + h2] : 0.f; } }
            v4u w; w.x = pk2(o[0], o[1]); w.y = pk2(o[2], o[3]); w.z = pk2(o[4], o[5]); w.w = pk2(o[6], o[7]);
            *(v4u*)(CT + (size_t)n * 384 + k0) = w; }
        bf16* BPT = (bf16*)(ws + WS_BPT) + (size_t)g * 256 * 256;
        for (int v = tid; v < 256 * 32; v += 512) { const int n = v >> 5, k0 = (v & 31) * 8; float o[8];
#pragma unroll
            for (int i = 0; i < 8; ++i) { const int k = k0 + i, s = k >> 4, h2 = k & 15;
                if (n < 128) { const int p = n & 63; const float ar = pwr[(15 - s) * 64 + p], ai = pwi[(15 - s) * 64 + p], br = bbr[p * 16 + h2], bi = bbi[p * 16 + h2];
                    o[i] = (n < 64) ? (ar * br - ai * bi) : (ar * bi + ai * br); }
                else o[i] = 0.f; }
            v4u w; w.x = pk2(o[0], o[1]); w.y = pk2(o[2], o[3]); w.z = pk2(o[4], o[5]); w.w = pk2(o[6], o[7]);
            *(v4u*)(BPT + (size_t)n * 256 + k0) = w; }
        __syncthreads();
    }
    {
        const int gt = F.vcu * (NWAVES * 64) + F.tid;
        float* biasr = (float*)(ws + WS_SMALL + SM_BIASR);
        if (gt < NPROJ) { const int sc = proj_src_col(gt); biasr[gt] = sc >= 0 ? A.in[I_BIN][sc] : 0.f; }
        float* lut = (float*)(ws + WS_SMALL + SM_LUT);
        if (gt >= 8192 && gt < 8192 + 1024) { const int e = gt - 8192, dist = e >> 3, h = e & 7; lut[e] = A.in[I_RELB][t5_bucket(dist) * 8 + h]; }
        bf16* wr = (bf16*)(ws + WS_WRT);
        for (int e = gt; e < 512 * 1024; e += F.G * NWAVES * 64) { const int r = e >> 10, k = e & 1023; int n = -1, lo = 0;
            if (r < 72) n = r; else if (r >= 128 && r < 200) { n = r - 128; lo = 1; } else if (r >= 256 && r < 328) n = r - 256;
            float o = 0.f;
            if (n >= 0) { const float w = n < 8 ? A.in[I_RWG][k * 8 + n] : A.in[I_RWE][k * 64 + (n - 8)]; const float hi = __uint_as_float(pk2(w, 0.f) << 16); o = lo ? w - hi : w; }
            wr[e] = (bf16)(pk2(o, 0.f) & 0xffffu); }
        if (gw >= 1024 && gw < 1024 + 256) { const int o = gw - 1024, j = o >> 7, c = o & 127; float s = 0.f;
            for (int i = lane; i < 2048; i += 64) s += A.in[I_CPOS][j * 2048 + i] * A.in[I_CW1][((size_t)j * 2048 + i) * 128 + c];
            s = wave_sum(s); if (lane == 0) ((float*)(ws + WS_SMALL + SM_B1C))[o] = s + A.in[I_CB1][o]; }
    }
    {
        LAS float* scr = (LAS float*)(F.lds + RING_OFF + 32768 + F.wave * 8704);
        constexpr int I_WI = 16 * 128, I_WA = 8 * 32, I_WV = 8 * 64, I_WO = 16 * 32, I_W1 = 2 * 32 * 8;
        constexpr int NITEMS = I_WI + I_WA + I_WV + I_WO + I_W1;
        const int nl = lane & 31;
        for (int it = gw; it < NITEMS; it += NGW) {
            int r = it;
            if (r < I_WI) { const int kb = r / 128, nb = r % 128, n = nb * 32 + nl, sc = proj_src_col(n);
                tr_item(sc >= 0 ? A.in[I_WIN] + sc : nullptr, D_IN, kb * 64, (bf16*)(ws + WS_WINT) + (size_t)(nb * 32) * 1024 + kb * 64, 1024, scr, lane); continue; } r -= I_WI;
            if (r < I_WA) { const int kb = r / 32, nb = r % 32, n = nb * 32 + nl;
                tr_item(A.in[I_WATT] + n, 1024, kb * 64, (bf16*)(ws + WS_WAT) + (size_t)(nb * 32) * 512 + kb * 64, 512, scr, lane); continue; } r -= I_WA;
            if (r < I_WV) { const int kb = r / 64, nb = r % 64, n = nb * 32 + nl, pn = n >> 8, rr = n & 255;
                const float* src = (rr < 128 ? A.in[I_WVAL] : A.in[I_WGATE]) + pn * 128 + (rr & 127);
                tr_item(src, 1024, kb * 64, (bf16*)(ws + WS_WVGT) + (size_t)(nb * 32) * 512 + kb * 64, 512, scr, lane); continue; } r -= I_WV;
            if (r < I_WO) { const int kb = r / 32, nb = r % 32, n = nb * 32 + nl;
                tr_item(A.in[I_WOUT] + n, 1024, kb * 64, (bf16*)(ws + WS_WOT) + (size_t)(nb * 32) * 1024 + kb * 64, 1024, scr, lane); continue; } r -= I_WO;
            if (r < I_W1) { const int j = r / 256, q = r % 256, kb = q / 8, nb = q % 8, n = nb * 32 + nl;
                tr_item(n < 128 ? A.in[I_CW1] + (size_t)j * 2048 * 128 + n : nullptr, 128, kb * 64, (bf16*)(ws + WS_W1CT) + ((size_t)j * 256 + nb * 32) * 2048 + kb * 64, 2048, scr, lane); }
        }
    }
#pragma unroll 2
    for (int m = gw; m < NTOK; m += NGW) {
        const f32x4* xr = (const f32x4*)(A.in[I_X] + (size_t)m * DM) + lane; v2u* o8 = (v2u*)((bf16*)(ws + WS_XB) + (size_t)m * DM) + lane;
#pragma unroll
        for (int j = 0; j < 4; ++j) { const f32x4 v = xr[64 * j]; v2u w; w.x = pk2(v.x, v.y); w.y = pk2(v.z, v.w); o8[64 * j] = w; }
    }
}

__device__ __forceinline__ TrItem expert_item(const Args& A, unsigned char* ws, int r, int nl) {
    constexpr int I_GU = 64 * 256;
    if (r < I_GU) { const int e = r / 256, q = r % 256, kb = q / 16, nb = q % 16, n = nb * 32 + nl, pn = n >> 8, rr = n & 255;
        const float* src = (rr < 128 ? A.in[I_EWG] : A.in[I_EWU]) + (size_t)e * 1024 * 256 + pn * 128 + (rr & 127);
        return TrItem{src, 256, kb * 64, 1024, (bf16*)(ws + WS_WGUT) + ((size_t)e * 512 + nb * 32) * 1024 + kb * 64}; }
    r -= I_GU;
    const int e = r / 128, q = r % 128, kb = q / 32, nb = q % 32, n = nb * 32 + nl;
    return TrItem{A.in[I_EWD] + (size_t)e * 256 * 1024 + n, 1024, kb * 64, 256, (bf16*)(ws + WS_WDT) + ((size_t)e * 1024 + nb * 32) * 256 + kb * 64};
}
__device__ __forceinline__ void expert_transposes(Frame& F, const Args& A, int wg0) {
    unsigned char* ws = F.ws; const int lane = F.lane, nl = lane & 31;
    LAS float* scr = (LAS float*)(F.lds + RING_OFF + F.wave * 8704);
    constexpr int NIT = 64 * 256 + 64 * 128;
    const int gw = (F.vcu - wg0) * NWAVES + F.wave, NGW = (F.G - wg0) * NWAVES;
    float ta[32], tb[32];
    int it = gw;
    if (it < NIT) { TrItem cur = expert_item(A, ws, it, nl); tr_load(cur, ta, lane);
#pragma unroll 1
        for (;;) {
            const int it2 = it + NGW; TrItem nxt = cur;
            if (it2 < NIT) { nxt = expert_item(A, ws, it2, nl); tr_load(nxt, tb, lane); }
            tr_store(cur, ta, scr, lane);
            if (it2 >= NIT) break;
            const int it3 = it2 + NGW; cur = nxt;
            if (it3 < NIT) { cur = expert_item(A, ws, it3, nl); tr_load(cur, ta, lane); }
            tr_store(nxt, tb, scr, lane);
            if (it3 >= NIT) break;
            it = it3;
        }
    }
    __syncthreads();
}

typedef pg8::f32x4 (AccT)[2][2][4][2];
constexpr float QSCALE = 0.125f * 1.4426950408889634f;
struct EpiProj {
    static constexpr bool PERM = true, AFTER_DRAIN = false;
    bf16 *Q, *KV, *SA, *MG, *G; const float* bias;
    __device__ __forceinline__ void operator()(const AccT& acc, const pg8::Unit& u, int wr, int wc, int fr, int fq) const {
        const int pn = u.pn, row0 = u.pm * 256 + wr * 64 + fr;
#pragma unroll
        for (int bj = 0; bj < 2; ++bj) {
            const int cl = bj * 128 + wc * 32 + 8 * fq, nc = pn * 256 + cl;
            const f32x4 b0 = *(const f32x4*)(bias + nc), b1 = *(const f32x4*)(bias + nc + 4);
#pragma unroll
            for (int ai = 0; ai < 2; ++ai)
#pragma unroll
                for (int m = 0; m < 4; ++m) {
                    const int row = row0 + ai * 128 + m * 16;
                    f32x4 v0 = acc[ai][bj][m][0] + b0, v1 = acc[ai][bj][m][1] + b1;
                    bf16* dst;
                    if (pn < 2) { v0 = v0 * QSCALE; v1 = v1 * QSCALE; dst = Q + (size_t)row * 512 + nc; }
                    else if (pn < 5) { const int kc = nc - 512, j = kc >> 7, g = (kc >> 6) & 1, d = kc & 63, b = row >> 12, t = row & 4095; dst = KV + ((((size_t)j * 8 + b) * 2 + g) * 4096 + t) * 64 + d; }
                    else if (pn < 7) { const int uc = nc - 1280, grp = uc >> 4, h = uc & 15, b = row >> 12, t = row & 4095; dst = SA + ((size_t)grp * 2048 + b * 256 + (t >> 4)) * 384 + 128 + (t & 15) * 16 + h; }
                    else {
                        v0.x = sigmoidf_(v0.x); v0.y = sigmoidf_(v0.y); v0.z = sigmoidf_(v0.z); v0.w = sigmoidf_(v0.w);
                        v1.x = sigmoidf_(v1.x); v1.y = sigmoidf_(v1.y); v1.z = sigmoidf_(v1.z); v1.w = sigmoidf_(v1.w);
                        if (pn < 15) dst = MG + (size_t)row * 2048 + (nc - 1792);
                        else { if (cl >= 24) continue; dst = G + (size_t)row * 32 + cl; }
                    }
                    v4u w; w.x = pk2(v0.x, v0.y); w.y = pk2(v0.z, v0.w); w.z = pk2(v1.x, v1.y); w.w = pk2(v1.z, v1.w);
                    *(v4u*)dst = w;
                }
        }
    }
};
template <bool GELU> struct EpiF32Half {
    static constexpr bool PERM = false, AFTER_DRAIN = false;
    float* O; const float* bias;
    __device__ __forceinline__ void operator()(const AccT& acc, const pg8::Unit& u, int wr, int wc, int fr, int fq) const {
        const int row0 = u.pm * 256 + wr * 64 + fr;
#pragma unroll
        for (int n = 0; n < 2; ++n) {
            const int c = wc * 32 + 16 * n + 4 * fq;
            f32x4 bv = (f32x4){0.f, 0.f, 0.f, 0.f}; if (bias) bv = *(const f32x4*)(bias + u.pn * 128 + c);
#pragma unroll
            for (int ai = 0; ai < 2; ++ai)
#pragma unroll
                for (int m = 0; m < 4; ++m) { f32x4 v = acc[ai][0][m][n] + bv;
                    if (GELU) { v.x = gelu_tanh(v.x); v.y = gelu_tanh(v.y); v.z = gelu_tanh(v.z); v.w = gelu_tanh(v.w); }
                    *(f32x4*)(O + (size_t)(row0 + ai * 128 + m * 16) * 128 + c) = v; }
        }
    }
};
struct EpiS5Y {
    static constexpr bool PERM = true, AFTER_DRAIN = false;
    bf16* Z;
    __device__ __forceinline__ void operator()(const AccT& acc, const pg8::Unit& u, int wr, int wc, int fr, int fq) const {
        const int g = u.pn, b = u.pm & 7, ch0 = wr * 64 + fr;
#pragma unroll
        for (int bj = 0; bj < 2; ++bj) { const int n0 = bj * 128 + wc * 32 + 8 * fq, tau = n0 >> 4, h = n0 & 15;
            bf16* zp = Z + ((size_t)b * 4096 + ch0 * 16 + tau) * 512 + g * 16 + h;
#pragma unroll
            for (int ai = 0; ai < 2; ++ai)
#pragma unroll
                for (int m = 0; m < 4; ++m) {
                    const f32x4 v0 = acc[ai][bj][m][0], v1 = acc[ai][bj][m][1];
                    v4u w; w.x = pk2(gelu_tanh(v0.x), gelu_tanh(v0.y)); w.y = pk2(gelu_tanh(v0.z), gelu_tanh(v0.w)); w.z = pk2(gelu_tanh(v1.x), gelu_tanh(v1.y)); w.w = pk2(gelu_tanh(v1.z), gelu_tanh(v1.w));
                    *(v4u*)(zp + (size_t)(ai * 128 + m * 16) * 16 * 512) = w; asm volatile("" ::: "memory"); } }
    }
};
struct EpiYa {
    static constexpr bool PERM = true, AFTER_DRAIN = false;
    bf16* T; const bf16* MG;
    __device__ __forceinline__ void operator()(const AccT& acc, const pg8::Unit& u, int wr, int wc, int fr, int fq) const {
        const int row0 = u.pm * 256 + wr * 64 + fr;
#pragma unroll
        for (int bj = 0; bj < 2; ++bj) { const int col = u.pn * 256 + bj * 128 + wc * 32 + 8 * fq;
#pragma unroll
            for (int ai = 0; ai < 2; ++ai)
#pragma unroll
                for (int m = 0; m < 4; ++m) { const int row = row0 + ai * 128 + m * 16;
                    const v4u g = *(const v4u*)(MG + (size_t)row * 2048 + col); const f32x4 v0 = acc[ai][bj][m][0], v1 = acc[ai][bj][m][1];
                    v4u w; w.x = pk2(v0.x * bflo(g.x), v0.y * bfhi(g.x)); w.y = pk2(v0.z * bflo(g.y), v0.w * bfhi(g.y)); w.z = pk2(v1.x * bflo(g.z), v1.y * bfhi(g.z)); w.w = pk2(v1.z * bflo(g.w), v1.w * bfhi(g.w));
                    *(v4u*)(T + (size_t)row * 1024 + col) = w; } }
    }
};
struct EpiYb {
    static constexpr bool PERM = true, AFTER_DRAIN = false;
    const bf16* T; const bf16* MG; const float* bg; bf16* MX;
    __device__ __forceinline__ void operator()(const AccT& acc, const pg8::Unit& u, int wr, int wc, int fr, int fq) const {
        const int row0 = u.pm * 256 + wr * 64 + fr, col = u.pn * 128 + wc * 32 + 8 * fq;
        const f32x4 b0 = *(const f32x4*)(bg + col), b1 = *(const f32x4*)(bg + col + 4);
#pragma unroll
        for (int ai = 0; ai < 2; ++ai)
#pragma unroll
            for (int m = 0; m < 4; ++m) { const int row = row0 + ai * 128 + m * 16;
                const v4u g = *(const v4u*)(MG + (size_t)row * 2048 + 1024 + col); const v4u t = *(const v4u*)(T + (size_t)row * 1024 + col);
                const f32x4 a0 = acc[ai][0][m][0], a1 = acc[ai][0][m][1], g0 = acc[ai][1][m][0] + b0, g1 = acc[ai][1][m][1] + b1;
                float o[8];
                o[0] = bflo(t.x) + bflo(g.x) * a0.x * sigmoidf_(g0.x); o[1] = bfhi(t.x) + bfhi(g.x) * a0.y * sigmoidf_(g0.y);
                o[2] = bflo(t.y) + bflo(g.y) * a0.z * sigmoidf_(g0.z); o[3] = bfhi(t.y) + bfhi(g.y) * a0.w * sigmoidf_(g0.w);
                o[4] = bflo(t.z) + bflo(g.z) * a1.x * sigmoidf_(g1.x); o[5] = bfhi(t.z) + bfhi(g.z) * a1.y * sigmoidf_(g1.y);
                o[6] = bflo(t.w) + bflo(g.w) * a1.z * sigmoidf_(g1.z); o[7] = bfhi(t.w) + bfhi(g.w) * a1.w * sigmoidf_(g1.w);
                v4u w; w.x = pk2(o[0], o[1]); w.y = pk2(o[2], o[3]); w.z = pk2(o[4], o[5]); w.w = pk2(o[6], o[7]);
                *(v4u*)(MX + (size_t)row * 1024 + col) = w; }
    }
};
struct EpiOut {
    static constexpr bool PERM = false, AFTER_DRAIN = false;
    const float* X; float* V;
    __device__ __forceinline__ void operator()(const AccT& acc, const pg8::Unit& u, int wr, int wc, int fr, int fq) const {
        const int row0 = u.pm * 256 + wr * 64 + fr;
#pragma unroll
        for (int bj = 0; bj < 2; ++bj)
#pragma unroll
            for (int n = 0; n < 2; ++n) { const int col = u.pn * 256 + bj * 128 + wc * 32 + 16 * n + 4 * fq;
#pragma unroll
                for (int ai = 0; ai < 2; ++ai)
#pragma unroll
                    for (int m = 0; m < 4; ++m) { const size_t o = (size_t)(row0 + ai * 128 + m * 16) * 1024 + col;
                        const f32x4 x = *(const f32x4*)(X + o); *(f32x4*)(V + o) = x * DN_ALPHA + acc[ai][bj][m][n]; } }
    }
};
struct EpiMoe1 {
    static constexpr bool PERM = true, AFTER_DRAIN = false;
    bf16* HB;
    __device__ __forceinline__ void operator()(const AccT& acc, const pg8::Unit& u, int wr, int wc, int fr, int fq) const {
        const int row0 = u.pm * 256 + wr * 64 + fr, col = (u.pn & 1) * 128 + wc * 32 + 8 * fq;
#pragma unroll
        for (int ai = 0; ai < 2; ++ai)
#pragma unroll
            for (int m = 0; m < 4; ++m) { const f32x4 g0 = acc[ai][0][m][0], g1 = acc[ai][0][m][1], u0 = acc[ai][1][m][0], u1 = acc[ai][1][m][1];
                v4u w; w.x = pk2(g0.x * sigmoidf_(g0.x) * u0.x, g0.y * sigmoidf_(g0.y) * u0.y); w.y = pk2(g0.z * sigmoidf_(g0.z) * u0.z, g0.w * sigmoidf_(g0.w) * u0.w);
                w.z = pk2(g1.x * sigmoidf_(g1.x) * u1.x, g1.y * sigmoidf_(g1.y) * u1.y); w.w = pk2(g1.z * sigmoidf_(g1.z) * u1.z, g1.w * sigmoidf_(g1.w) * u1.w);
                *(v4u*)(HB + (size_t)(row0 + ai * 128 + m * 16) * 256 + col) = w; }
    }
};
struct EpiMoe2 {
    static constexpr bool PERM = true, AFTER_DRAIN = false;
    bf16* Y;
    __device__ __forceinline__ void operator()(const AccT& acc, const pg8::Unit& u, int wr, int wc, int fr, int fq) const {
        const int row0 = u.pm * 256 + wr * 64 + fr;
#pragma unroll
        for (int bj = 0; bj < 2; ++bj) { const int col = (u.pn & 3) * 256 + bj * 128 + wc * 32 + 8 * fq;
#pragma unroll
            for (int ai = 0; ai < 2; ++ai)
#pragma unroll
                for (int m = 0; m < 4; ++m) { const f32x4 v0 = acc[ai][bj][m][0], v1 = acc[ai][bj][m][1];
                    v4u w; w.x = pk2(v0.x, v0.y); w.y = pk2(v0.z, v0.w); w.z = pk2(v1.x, v1.y); w.w = pk2(v1.z, v1.w);
                    *(v4u*)(Y + (size_t)(row0 + ai * 128 + m * 16) * 1024 + col) = w; } }
    }
};
struct EpiRouter {
    static constexpr bool PERM = false, AFTER_DRAIN = true;
    const float* bg; const float* be; int* route; int* hist;
    __device__ __forceinline__ void fused(const AccT& acc, const pg8::Unit& u, int wr, int wc, int fr, int fq, PG8_LAS unsigned char* lds, int wid, int lane) const {
        PG8_LAS float* LG = (PG8_LAS float*)lds;
        PG8_LAS int* lh = (PG8_LAS int*)(lds + 256 * 76 * 4);
        const int tid = wid * 64 + lane;
        if (tid < 64) lh[tid] = 0;
        if (wc < 3) {
#pragma unroll
            for (int n = 0; n < 2; ++n) { const int c = wc * 32 + 16 * n + 4 * fq;
                if (c < 72) {
#pragma unroll
                    for (int ai = 0; ai < 2; ++ai)
#pragma unroll
                        for (int m = 0; m < 4; ++m) { const pg8::f32x4 v = acc[ai][0][m][n] + acc[ai][1][m][n]; *(PG8_LAS pg8::f32x4*)(LG + (ai * 128 + wr * 64 + m * 16 + fr) * 76 + c) = v; } } }
        }
        asm volatile("s_waitcnt lgkmcnt(0)" ::: "memory"); __builtin_amdgcn_s_barrier(); asm volatile("" ::: "memory");
        const int wg = u.pm - 128;
        if (tid < 256) {
            const PG8_LAS float* l = LG + tid * 76; const int row = wg * 256 + tid;
            float gm = -3.0e38f; int gi = 0; float gl[8];
#pragma unroll
            for (int j = 0; j < 8; ++j) { gl[j] = l[j] + bg[j]; if (gl[j] > gm) { gm = gl[j]; gi = j; } }
            float ge = 0.f;
#pragma unroll
            for (int j = 0; j < 8; ++j) ge += __expf(gl[j] - gm);
            const float pgroup = 1.0f / ge;
            float m1 = -3.0e38f, m2 = -3.0e38f; int i1 = 0, i2 = 0;
#pragma unroll
            for (int j = 0; j < 8; ++j) { const float v = l[8 + gi * 8 + j] + be[gi * 8 + j];
                if (v > m1) { m2 = m1; i2 = i1; m1 = v; i1 = j; } else if (v > m2) { m2 = v; i2 = j; } }
            const float e2 = __expf(m2 - m1), w1 = pgroup / (1.0f + e2), w2 = pgroup * e2 / (1.0f + e2);
            int* rt = route + (size_t)row * 8; const int ex1 = gi * 8 + i1, ex2 = gi * 8 + i2;
            const int r1 = __hip_atomic_fetch_add(lh + ex1, 1, __ATOMIC_RELAXED, __HIP_MEMORY_SCOPE_WORKGROUP), r2 = __hip_atomic_fetch_add(lh + ex2, 1, __ATOMIC_RELAXED, __HIP_MEMORY_SCOPE_WORKGROUP);
            rt[0] = ex1; rt[1] = ex2; rt[2] = __float_as_int(w1); rt[3] = __float_as_int(w2); rt[4] = r1; rt[5] = r2;
        }
        asm volatile("s_waitcnt lgkmcnt(0)" ::: "memory"); __builtin_amdgcn_s_barrier(); asm volatile("" ::: "memory");
        if (tid < 64) hist[wg * 64 + tid] = lh[tid];
    }
};
struct RouterOrder {
    int c;
    __device__ __forceinline__ bool next(int i, pg8::Unit& u) const { if (c >= 128 || i >= 2) return false; u.pm = c + 128 * i; u.pn = i; return true; }
    __device__ __forceinline__ void a_ready(const pg8::Unit&) const {}
    __device__ __forceinline__ void done(const pg8::Unit&) const {}
};
struct ListOrder {
    int n, G, c, per, div;
    __device__ __forceinline__ bool next(int i, pg8::Unit& u) const { const int L = i * G + c; if (L >= n) return false; u.pm = L / per; u.pn = (u.pm / div) * per + L % per; return true; }
    __device__ __forceinline__ void a_ready(const pg8::Unit&) const {}
    __device__ __forceinline__ void done(const pg8::Unit&) const {}
};
struct MoeOrder {
    int n, G, c, per; const LAS unsigned char* tile_e;
    __device__ __forceinline__ bool next(int i, pg8::Unit& u) const { const int L = i * G + c; if (L >= n) return false; u.pm = L / per; u.pn = (int)tile_e[u.pm] * per + L % per; return true; }
    __device__ __forceinline__ void a_ready(const pg8::Unit&) const {}
    __device__ __forceinline__ void done(const pg8::Unit&) const {}
};

__device__ __forceinline__ void p3_thin(Frame& F, const Args& A) {
    unsigned char* ws = F.ws;
    {
        const float* HID = (const float*)(ws + WS_HID); bf16* KC = (bf16*)(ws + WS_KC);
        const int total = 2 * 4096 * 64;
        for (int o = F.vcu * 512 + F.tid; o < total; o += F.G * 512) {
            const int d = o & 63, row = o >> 6, j = row >> 12;
            const float* h = HID + (size_t)row * 128; const float* w = A.in[I_CW2] + (size_t)j * 128 * 64 + d;
            float s = A.in[I_CB2][j * 64 + d];
#pragma unroll 8
            for (int m = 0; m < 128; ++m) s += h[m] * w[m * 64];
            KC[o] = (bf16)(pk2(s, 0.f) & 0xffffu);
        }
    }
    if (F.wave == 0) {
        for (int gb = F.vcu; gb < 256; gb += F.G) {
            const int p = F.lane; const float* a16 = (const float*)(ws + WS_SMALL + SM_A16) + (size_t)((gb >> 3) * 64 + p) * 2; const float ar = a16[0], ai = a16[1];
            const float* E = (const float*)(ws + WS_E) + (size_t)gb * 256 * 128; bf16* SA = (bf16*)(ws + WS_SA) + (size_t)gb * 256 * 384;
            float xr = 0.f, xi = 0.f;
            for (int c0 = 0; c0 < 256; c0 += 8) {
                float er[8], ei[8];
#pragma unroll
                for (int k = 0; k < 8; ++k) { er[k] = E[(size_t)(c0 + k) * 128 + p]; ei[k] = E[(size_t)(c0 + k) * 128 + 64 + p]; }
#pragma unroll
                for (int k = 0; k < 8; ++k) { bf16* row = SA + (size_t)(c0 + k) * 384; row[p] = (bf16)(pk2(xr, 0.f) & 0xffffu); row[64 + p] = (bf16)(pk2(xi, 0.f) & 0xffffu);
                    const float nr = ar * xr - ai * xi + er[k], ni = ar * xi + ai * xr + ei[k]; xr = nr; xi = ni; }
            }
        }
    }
}


namespace att2 {
typedef short bf16x8 __attribute__((ext_vector_type(8)));
typedef short s16x4 __attribute__((ext_vector_type(4)));
typedef float f32x16 __attribute__((ext_vector_type(16)));
typedef short v4i16_t __attribute__((ext_vector_type(4)));
typedef LAS const char* lds_cptr;
#define A2_MFMA(a, b, c) __builtin_amdgcn_mfma_f32_32x32x16_bf16(a, b, c, 0, 0, 0)
constexpr int SLOTB = 8192, NSLOT = 4, L_K = 0, L_V = NSLOT * SLOTB, L_LUT = 2 * NSLOT * SLOTB, L_WS = L_LUT + 4096, WS_PER_WAVE = 7168;
constexpr int W_WSF = 0, W_TBL = 128, W_GATE = 256, W_IMP = 768, W_OST = 3072;
static_assert(L_WS + 8 * WS_PER_WAVE <= 131072, "attention LDS map");
constexpr float MASKED = -2.0e30f, MINIT = -1.0e30f, THR = 8.0f;
__device__ __forceinline__ int crow(int r, int hi) { return (r & 3) + 8 * (r >> 2) + 4 * hi; }
__device__ __forceinline__ s16x4 vtr(lds_cptr p) { return __builtin_bit_cast(s16x4, __builtin_amdgcn_ds_read_tr16_b64_v4i16((LAS v4i16_t*)p)); }
#define A2_MX3(a, b, c) __builtin_fmaxf(__builtin_fmaxf((a), (b)), (c))
__device__ __forceinline__ float rowmax(const f32x16& p0, const f32x16& p1) {
    float a = A2_MX3(p0[0], p0[1], p1[0]), b = A2_MX3(p0[2], p0[3], p1[1]); a = A2_MX3(a, p1[2], p1[3]);
#pragma unroll
    for (int r = 4; r < 16; r += 4) { a = A2_MX3(a, p0[r], p0[r + 1]); b = A2_MX3(b, p0[r + 2], p0[r + 3]); a = A2_MX3(a, p1[r], p1[r + 1]); b = A2_MX3(b, p1[r + 2], p1[r + 3]); }
    const float m = __builtin_fmaxf(a, b); auto rr = __builtin_amdgcn_permlane32_swap(__float_as_uint(m), __float_as_uint(m), false, false);
    return __builtin_fmaxf(__uint_as_float(rr[0]), __uint_as_float(rr[1])); }
__device__ __forceinline__ float halfsum(float v) { auto rr = __builtin_amdgcn_permlane32_swap(__float_as_uint(v), __float_as_uint(v), false, false); return __uint_as_float(rr[0]) + __uint_as_float(rr[1]); }

struct Ctx {
    LAS unsigned char* lds;
    int wid, lane, r32, hi;
    int tq;
    int hg;
    bf16x8 qr[4];
};
__device__ __forceinline__ void glds16(const void* g, unsigned lds_base) {
    unsigned sv; asm volatile("s_mov_b32 %0, m0\n\ts_mov_b32 m0, %2\n\ts_nop 0\n\tglobal_load_lds_dwordx4 %1, off\n\ts_mov_b32 m0, %0" : "=&s"(sv) : "v"(g), "s"(lds_base) : "memory"); }
__device__ __forceinline__ void stage(const Ctx& C, const bf16* ksrc, const bf16* vsrc, int slot) {
    const unsigned base = (unsigned)(uintptr_t)C.lds + (unsigned)(slot * SLOTB + C.wid * 1024);
    glds16(ksrc + (size_t)C.lane * 64 + C.wid * 8, (unsigned)__builtin_amdgcn_readfirstlane((int)(base + L_K)));
    glds16(vsrc + (size_t)(16 * (C.wid & 3) + (C.lane >> 2)) * 64 + (C.wid >> 2) * 32 + (C.lane & 3) * 8, (unsigned)__builtin_amdgcn_readfirstlane((int)(base + L_V)));
}
struct Pipe {
    const bf16 *KV, *KC; int w;
    int k, pass, idx, n; const bf16 *kb, *vb;
    int issued, s;
    __device__ __forceinline__ int qt_of(int kk) const { const int r = w & 15; return kk == 0 ? r : (kk == 1 ? 31 - r : (kk == 2 ? 32 + r : 63 - r)); }
    __device__ __forceinline__ void setup_pass() {
        const int bg = w >> 4, qt = qt_of(k); const size_t kvslab = (size_t)bg * 4096 * 64, kvstride = (size_t)NB * 2 * 4096 * 64;
        if (pass < 2) { n = (4 * qt + 66) >> 6; kb = KC + (size_t)bg * 256 * 64; vb = kb + (size_t)16 * 256 * 64; }
        else if (pass == 2) { n = qt + 1; kb = KV + 2 * kvstride + kvslab; vb = kb + kvstride; }
        else { const int j0 = qt > 8 ? qt - 8 : 0; n = qt - j0 + 1; kb = KV + 4 * kvstride + kvslab + (size_t)j0 * 4096; vb = kb + kvstride; }
    }
    __device__ __forceinline__ void init(const bf16* KV_, const bf16* KC_, int w_) { KV = KV_; KC = KC_; w = w_; k = 0; pass = 0; idx = 0; issued = 0; s = 0; setup_pass(); }
    __device__ __forceinline__ void issue_next(const Ctx& C) {
        if (k < 4) { stage(C, kb + (size_t)idx * 4096, vb + (size_t)idx * 4096, issued & (NSLOT - 1)); ++issued; ++idx;
            if (idx == n) { idx = 0; ++pass; if (pass == 4) { pass = 0; ++k; } if (k < 4) setup_pass(); } }
    }
    __device__ __forceinline__ void wait_bar(int pending) {
        if (pending >= 2) asm volatile("s_waitcnt vmcnt(4) lgkmcnt(0)" ::: "memory"); else if (pending == 1) asm volatile("s_waitcnt vmcnt(2) lgkmcnt(0)" ::: "memory"); else asm volatile("s_waitcnt vmcnt(0) lgkmcnt(0)" ::: "memory");
        __builtin_amdgcn_s_barrier(); asm volatile("" ::: "memory");
    }
    __device__ __forceinline__ void prologue(const Ctx& C) { issue_next(C); issue_next(C); issue_next(C); wait_bar(issued - 1); }
    __device__ __forceinline__ int slot() const { return s & (NSLOT - 1); }
    __device__ __forceinline__ void begin_step(const Ctx& C) { issue_next(C); }
    __device__ __forceinline__ void end_step() { wait_bar(issued - (s + 2)); ++s; }
};
__device__ __forceinline__ void scores(const Ctx& C, int slot, f32x16& s0, f32x16& s1) {
    const lds_cptr kp = (lds_cptr)C.lds + L_K + slot * SLOTB + C.hi * 1024 + C.r32 * 16;
    bf16x8 kf[8];
#pragma unroll
    for (int d0 = 0; d0 < 4; ++d0) { kf[2 * d0] = *(const LAS bf16x8*)(kp + d0 * 2048); kf[2 * d0 + 1] = *(const LAS bf16x8*)(kp + d0 * 2048 + 512); }
    f32x16 z;
#pragma unroll
    for (int i = 0; i < 16; ++i) z[i] = 0.f;
    s0 = A2_MFMA(kf[0], C.qr[0], z); s1 = A2_MFMA(kf[1], C.qr[0], z);
    s0 = A2_MFMA(kf[2], C.qr[1], s0); s1 = A2_MFMA(kf[3], C.qr[1], s1);
    s0 = A2_MFMA(kf[4], C.qr[2], s0); s1 = A2_MFMA(kf[5], C.qr[2], s1);
    s0 = A2_MFMA(kf[6], C.qr[3], s0); s1 = A2_MFMA(kf[7], C.qr[3], s1);
}
__device__ __forceinline__ void bias_far(f32x16& s0, f32x16& s1, float cl) {
#pragma unroll
    for (int r = 0; r < 16; ++r) { s0[r] += cl; s1[r] += cl; }
}
__device__ __forceinline__ void bias_near(const Ctx& C, f32x16& s0, f32x16& s1, int kbase, int kstep, int maxd, bool colsel) {
    const unsigned lutb = (unsigned)(uintptr_t)(C.lds + L_LUT) + (unsigned)C.hg * 4u;
    const int d0 = C.tq - kbase - kstep * 4 * C.hi;
#pragma unroll
    for (int half = 0; half < 2; ++half) {
        f32x16& sx = half ? s1 : s0; const int dh = d0 - half * 32 * kstep;
#pragma unroll
        for (int q4 = 0; q4 < 2; ++q4) {
            unsigned ad[8]; float bb[8];
#pragma unroll
            for (int i = 0; i < 8; ++i) { const int r = q4 * 8 + i; const int da = dh - kstep * ((r & 3) + 8 * (r >> 2)); const int ia = da < 0 ? 0 : (da > 127 ? 127 : da); ad[i] = lutb + (unsigned)ia * 32u; }
            asm volatile("ds_read_b32 %0, %8\n\tds_read_b32 %1, %9\n\tds_read_b32 %2, %10\n\tds_read_b32 %3, %11\n\tds_read_b32 %4, %12\n\tds_read_b32 %5, %13\n\tds_read_b32 %6, %14\n\tds_read_b32 %7, %15\n\ts_waitcnt lgkmcnt(0)"
                         : "=&v"(bb[0]), "=&v"(bb[1]), "=&v"(bb[2]), "=&v"(bb[3]), "=&v"(bb[4]), "=&v"(bb[5]), "=&v"(bb[6]), "=&v"(bb[7])
                         : "v"(ad[0]), "v"(ad[1]), "v"(ad[2]), "v"(ad[3]), "v"(ad[4]), "v"(ad[5]), "v"(ad[6]), "v"(ad[7]) : "memory");
#pragma unroll
            for (int i = 0; i < 8; ++i) { const int r = q4 * 8 + i; const int da = dh - kstep * ((r & 3) + 8 * (r >> 2)); const bool ok = colsel && da >= 0 && da <= maxd; const float v = sx[r] + bb[i]; sx[r] = ok ? v : MASKED; }
        }
    }
}
struct Acc { f32x16 o[2]; float m, l; };
__device__ __forceinline__ void acc_zero(Acc& a) {
#pragma unroll
    for (int i = 0; i < 16; ++i) { a.o[0][i] = 0.f; a.o[1][i] = 0.f; }
    a.m = MINIT; a.l = 0.f;
}
__device__ __forceinline__ void pv(const Ctx& C, int slot, const f32x16& p0, const f32x16& p1, f32x16 (&o)[2]) {
    v4u pw[4];
#pragma unroll
    for (int k = 0; k < 2; ++k) { pw[k] = (v4u){pk2(p0[8 * k], p0[8 * k + 1]), pk2(p0[8 * k + 2], p0[8 * k + 3]), pk2(p0[8 * k + 4], p0[8 * k + 5]), pk2(p0[8 * k + 6], p0[8 * k + 7])};
                                  pw[2 + k] = (v4u){pk2(p1[8 * k], p1[8 * k + 1]), pk2(p1[8 * k + 2], p1[8 * k + 3]), pk2(p1[8 * k + 4], p1[8 * k + 5]), pk2(p1[8 * k + 6], p1[8 * k + 7])}; }
    const lds_cptr vp = (lds_cptr)C.lds + L_V + slot * SLOTB + ((C.lane >> 4) & 1) * 32 + (C.lane & 3) * 8 + (4 * C.hi + ((C.lane & 15) >> 2)) * 64;
#pragma unroll
    for (int dh = 0; dh < 2; ++dh) {
        s16x4 vlo[4], vhi[4];
#pragma unroll
        for (int k = 0; k < 4; ++k) { vlo[k] = vtr(vp + dh * 4096 + k * 1024); vhi[k] = vtr(vp + dh * 4096 + k * 1024 + 512); }
#pragma unroll
        for (int k = 0; k < 4; ++k) { const bf16x8 vf = (bf16x8){vlo[k][0], vlo[k][1], vlo[k][2], vlo[k][3], vhi[k][0], vhi[k][1], vhi[k][2], vhi[k][3]};
            o[dh] = A2_MFMA(__builtin_bit_cast(bf16x8, pw[k]), vf, o[dh]); }
    }
}
__device__ __forceinline__ void softmax_step(const Ctx& C, Acc& a, f32x16& s0, f32x16& s1, float cl) {
    LAS float* wsf = (LAS float*)(C.lds + L_WS + C.wid * WS_PER_WAVE + W_WSF);
    const float mt = rowmax(s0, s1) + cl;
    if (__any(mt - a.m > THR)) {
        const float mn = __builtin_fmaxf(a.m, mt), f = __builtin_amdgcn_exp2f(a.m - mn);
        a.l *= f; a.m = mn;
        if (C.hi == 0) wsf[C.r32] = f;
        asm volatile("s_waitcnt lgkmcnt(0)" ::: "memory");
#pragma unroll
        for (int r = 0; r < 16; ++r) { const float fr = wsf[crow(r, C.hi)]; a.o[0][r] *= fr; a.o[1][r] *= fr; }
        asm volatile("s_waitcnt lgkmcnt(0)" ::: "memory");
    }
    const float nm = cl - a.m; float sacc = 0.f;
#pragma unroll
    for (int r = 0; r < 16; ++r) { s0[r] = __builtin_amdgcn_exp2f(s0[r] + nm); s1[r] = __builtin_amdgcn_exp2f(s1[r] + nm); sacc += s0[r] + s1[r]; }
    a.l += sacc;
}
__device__ __forceinline__ void fold(const Ctx& C, const Acc& a, int branch, f32x16 (&out)[2]) {
    LAS float* tbl = (LAS float*)(C.lds + L_WS + C.wid * WS_PER_WAVE + W_TBL);
    const LAS float* gate = (const LAS float*)(C.lds + L_WS + C.wid * WS_PER_WAVE + W_GATE);
    const float l = halfsum(a.l);
    if (C.hi == 0) tbl[C.r32] = (l > 0.f ? __builtin_amdgcn_rcpf(l) : 0.f) * gate[C.r32 * 4 + branch];
    asm volatile("s_waitcnt lgkmcnt(0)" ::: "memory");
#pragma unroll
    for (int r = 0; r < 16; ++r) { const float f = tbl[crow(r, C.hi)]; out[0][r] += f * a.o[0][r]; out[1][r] += f * a.o[1][r]; }
    asm volatile("s_waitcnt lgkmcnt(0)" ::: "memory");
}

__device__ __forceinline__ void unit(Ctx& C, Pipe& P, int b, int g, int qt, const bf16* Q, const bf16* GT, bf16* O) {
    LAS unsigned char* lds = C.lds; const int wid = C.wid, lane = C.lane;
    const int t0 = qt * 64, ql = C.r32 >> 2, hl = C.r32 & 3;
    C.tq = t0 + 8 * wid + ql; C.hg = g * 4 + hl;
    const size_t row = (size_t)b * 4096 + C.tq;
    LAS unsigned char* wsb = lds + L_WS + wid * WS_PER_WAVE;
#pragma unroll
    for (int d0 = 0; d0 < 4; ++d0) C.qr[d0] = *(const bf16x8*)(Q + row * 512 + C.hg * 64 + d0 * 16 + C.hi * 8);
    if (C.hi == 0) { LAS float* gate = (LAS float*)(wsb + W_GATE);
#pragma unroll
        for (int br = 0; br < 3; ++br) gate[C.r32 * 4 + br] = bf2f(GT[row * 32 + C.hg * 3 + br]); }
    { LAS float* imp = (LAS float*)(wsb + W_IMP);
#pragma unroll
        for (int i = 0; i < 8; ++i) imp[lane + 64 * i] = 0.f; }
    const float lut31 = ((const LAS float*)(lds + L_LUT))[127 * 8 + C.hg];
    f32x16 out[2];
#pragma unroll
    for (int i = 0; i < 16; ++i) { out[0][i] = 0.f; out[1][i] = 0.f; }
    Acc a; f32x16 s0, s1;
    const int tmax = t0 + 63, nvis_max = tmax >= 31 ? ((tmax - 31) >> 4) + 1 : 0, ntc = (nvis_max + 63) >> 6;
    const int twmin = t0 + 8 * wid;
    float mc = MINIT, lc = 0.f;
#pragma unroll 1
    for (int tl = 0; tl < ntc; ++tl) {
        P.begin_step(C);
        scores(C, P.slot(), s0, s1);
        float cl = 0.f;
        if (twmin - (16 * (64 * tl + 63) + 31) >= 113) cl = lut31; else bias_near(C, s0, s1, 16 * 64 * tl + 31, 16, 1 << 30, true);
        const float mt = rowmax(s0, s1) + cl, mn = __builtin_fmaxf(mc, mt); float sacc = 0.f; const float nm = cl - mn;
#pragma unroll
        for (int r = 0; r < 16; ++r) sacc += __builtin_amdgcn_exp2f(s0[r] + nm) + __builtin_amdgcn_exp2f(s1[r] + nm);
        lc = lc * __builtin_amdgcn_exp2f(mc - mn) + sacc; mc = mn;
        P.end_step();
    }
    { const float lf = halfsum(lc); lc = lf > 0.f ? __builtin_amdgcn_rcpf(lf) : 0.f; }
    acc_zero(a);
#pragma unroll 1
    for (int tl = 0; tl < ntc; ++tl) {
        P.begin_step(C);
        scores(C, P.slot(), s0, s1);
        float cl = 0.f;
        if (twmin - (16 * (64 * tl + 63) + 31) >= 113) cl = lut31; else bias_near(C, s0, s1, 16 * 64 * tl + 31, 16, 1 << 30, true);
        const float nm = cl - mc;
#pragma unroll
        for (int r = 0; r < 16; ++r) { s0[r] = __builtin_amdgcn_exp2f(s0[r] + nm) * lc; s1[r] = __builtin_amdgcn_exp2f(s1[r] + nm) * lc; }
        {
            LAS float* imp = (LAS float*)(wsb + W_IMP) + ql * 64;
#pragma unroll
            for (int aa = 0; aa < 4; ++aa) {
                const int nb0 = 16 * tl + 2 * aa + C.hi, nb1 = nb0 + 8;
                const float g0 = (s0[4 * aa] + s0[4 * aa + 1]) + (s0[4 * aa + 2] + s0[4 * aa + 3]), g1 = (s1[4 * aa] + s1[4 * aa + 1]) + (s1[4 * aa + 2] + s1[4 * aa + 3]);
                (void)__hip_atomic_fetch_add(imp + nb0, g0, __ATOMIC_RELAXED, __HIP_MEMORY_SCOPE_WORKGROUP);
                (void)__hip_atomic_fetch_add(imp + nb1, g1, __ATOMIC_RELAXED, __HIP_MEMORY_SCOPE_WORKGROUP);
                if (nb0 + 1 < 64) (void)__hip_atomic_fetch_add(imp + nb0 + 1, s0[4 * aa + 3], __ATOMIC_RELAXED, __HIP_MEMORY_SCOPE_WORKGROUP);
                if (nb1 + 1 < 64) (void)__hip_atomic_fetch_add(imp + nb1 + 1, s1[4 * aa + 3], __ATOMIC_RELAXED, __HIP_MEMORY_SCOPE_WORKGROUP);
            }
        }
        pv(C, P.slot(), s0, s1, a.o);
        P.end_step();
    }
    a.l = 0.5f;
    fold(C, a, 0, out);
    unsigned long long mymask = 0ull, anymask = 0ull;
    {
        const LAS float* imp = (const LAS float*)(wsb + W_IMP);
        const int n = lane; const bool forced = (n == 0) || (n == qt) || (n == qt - 1), val = n <= qt;
#pragma unroll 1
        for (int q8 = 0; q8 < 8; ++q8) {
            const float score = forced ? 1e9f : (val ? imp[q8 * 64 + n] : -1e9f);
            int rank = 0;
#pragma unroll 8
            for (int m = 0; m < 64; ++m) { const float sm = __uint_as_float(__builtin_amdgcn_readlane(__float_as_uint(score), m)); rank += (sm > score || (sm == score && m < n)) ? 1 : 0; }
            const unsigned long long sel = __ballot(rank < 16 && val);
            anymask |= sel; if (ql == q8) mymask = sel;
        }
    }
#pragma unroll 1
    for (int ph = 0; ph < 2; ++ph) {
        acc_zero(a);
        const int j0 = ph ? (qt > 8 ? qt - 8 : 0) : 0, nj = qt - j0 + 1, maxd = ph ? 511 : (1 << 30);
#pragma unroll 1
        for (int i = 0; i < nj; ++i) {
            const int j = j0 + i;
            P.begin_step(C);
            const bool wave_on = ph ? true : ((anymask >> j) & 1ull) != 0ull;
            if (wave_on) {
                const bool colsel = ph ? true : ((mymask >> j) & 1ull) != 0ull;
                scores(C, P.slot(), s0, s1);
                const bool far = (j <= qt - 3) && !(ph && j == qt - 8);
                float cl = 0.f;
                if (far) cl = colsel ? lut31 : MASKED; else bias_near(C, s0, s1, 64 * j, 1, maxd, colsel);
                softmax_step(C, a, s0, s1, cl);
                pv(C, P.slot(), s0, s1, a.o);
            }
            P.end_step();
        }
        fold(C, a, 1 + ph, out);
    }
    {
        bf16* stg = (bf16*)(wsb + W_OST);
#pragma unroll
        for (int r = 0; r < 16; ++r) { const int c = crow(r, C.hi);
            stg[c * 64 + C.r32] = (bf16)(pk2(out[0][r], 0.f) & 0xffffu); stg[c * 64 + 32 + C.r32] = (bf16)(pk2(out[1][r], 0.f) & 0xffffu); }
        asm volatile("s_waitcnt lgkmcnt(0)" ::: "memory");
#pragma unroll
        for (int i = 0; i < 4; ++i) { const int c = i * 8 + (lane >> 3), ch = lane & 7;
            const v4u v = *(const LAS v4u*)(stg + c * 64 + ch * 8);
            *(v4u*)(O + ((size_t)b * 4096 + t0 + 8 * wid + (c >> 2)) * 512 + (g * 4 + (c & 3)) * 64 + ch * 8) = v; }
        asm volatile("s_waitcnt lgkmcnt(0)" ::: "memory");
    }
}
}

__device__ __forceinline__ void p4_attention(Frame& F, const Args& A) {
    unsigned char* ws = F.ws;
    LAS unsigned char* lds = F.lds + RING_OFF;
    { LAS float* lut = (LAS float*)(lds + att2::L_LUT); for (int e = F.tid; e < 1024; e += 512) lut[e] = ((const float*)(ws + WS_SMALL + SM_LUT))[e] * 1.4426950408889634f; }
    __syncthreads();
    const bf16* Q = (const bf16*)(ws + WS_Q); const bf16* KV = (const bf16*)(ws + WS_KV); const bf16* KC = (const bf16*)(ws + WS_KC); const bf16* GT = (const bf16*)(ws + WS_G);
    bf16* O = (bf16*)(ws + WS_O);
#ifndef PROBE_ATTN_REPS
#define PROBE_ATTN_REPS 1
#endif
    for (int ww = F.vcu; ww < 256 * PROBE_ATTN_REPS; ww += F.G) {
        const int w = ww & 255; const int bg = w >> 4, b = bg >> 1, g = bg & 1;
        att2::Ctx C; C.lds = lds; C.wid = F.wave; C.lane = F.lane; C.r32 = F.lane & 31; C.hi = F.lane >> 5;
        att2::Pipe P; P.init(KV, KC, w); P.prologue(C);
#pragma unroll 1
        for (int k = 0; k < 4; ++k) att2::unit(C, P, b, g, P.qt_of(k), Q, GT, O);
        asm volatile("s_waitcnt vmcnt(0) lgkmcnt(0)" ::: "memory"); __builtin_amdgcn_s_barrier(); asm volatile("" ::: "memory");
    }
}

__device__ __forceinline__ void p8_ln(Frame& F, const Args& A) {
    unsigned char* ws = F.ws; const int lane = F.lane;
    float* H1 = (float*)(ws + WS_H1); bf16* H1B = (bf16*)(ws + WS_H1B); bf16* HLO = (bf16*)(ws + WS_HLO);
    const int gw = F.vcu * NWAVES + F.wave, NGW = F.G * NWAVES;
    f32x4 gam[4], bet[4];
#pragma unroll
    for (int j = 0; j < 4; ++j) { gam[j] = ((const f32x4*)A.in[I_LN1G])[lane + 64 * j]; bet[j] = ((const f32x4*)A.in[I_LN1B])[lane + 64 * j]; }
#pragma unroll 2
    for (int m = gw; m < NTOK; m += NGW) {
        f32x4* xr = (f32x4*)(H1 + (size_t)m * DM) + lane; f32x4 h[4]; float s = 0.f;
#pragma unroll
        for (int j = 0; j < 4; ++j) { h[j] = xr[64 * j]; s += (h[j].x + h[j].y) + (h[j].z + h[j].w); }
        const float mean = wave_sum(s) * (1.f / DM); float s2 = 0.f;
#pragma unroll
        for (int j = 0; j < 4; ++j) { h[j] = h[j] - mean; s2 += (h[j].x * h[j].x + h[j].y * h[j].y) + (h[j].z * h[j].z + h[j].w * h[j].w); }
        const float rstd = 1.0f / sqrtf(wave_sum(s2) * (1.f / DM) + LN_EPS);
        v2u* o8 = (v2u*)(H1B + (size_t)m * DM) + lane; v2u* l8 = (v2u*)(HLO + (size_t)m * DM) + lane;
#pragma unroll
        for (int j = 0; j < 4; ++j) { h[j] = h[j] * rstd * gam[j] + bet[j]; xr[64 * j] = h[j];
            v2u w; w.x = pk2(h[j].x, h[j].y); w.y = pk2(h[j].z, h[j].w); o8[64 * j] = w;
            v2u q; q.x = pk2(h[j].x - bflo(w.x), h[j].y - bfhi(w.x)); q.y = pk2(h[j].z - bflo(w.y), h[j].w - bfhi(w.y)); l8[64 * j] = q; }
    }
}
template <class P> __device__ __forceinline__ int moe_tables(Frame& F, P cnt, LAS int* pstart  , LAS unsigned char* tile_e  ) {
    LAS int* nt = (LAS int*)(pstart + 64);
    if (F.tid == 0) { int acc = 0;
        for (int e = 0; e < 64; ++e) { const int c = (int)cnt[e]; const int tiles = (c + 255) >> 8; pstart[e] = acc * 256;
            for (int k = 0; k < tiles; ++k) tile_e[acc + k] = (unsigned char)e; acc += tiles; }
        nt[0] = acc; }
    __syncthreads();
    return nt[0];
}
__device__ __forceinline__ void p9_scatter(Frame& F, const Args& A) {
    unsigned char* ws = F.ws; const int lane = F.lane;
    LAS int* pstart = (LAS int*)(F.lds + LTAB_OFF); LAS unsigned char* tile_e = (LAS unsigned char*)(F.lds + LTAB_OFF + 512);
    LAS int* pre = (LAS int*)(F.lds + RING_OFF);
    LAS int* tot = pre + 128 * 64;
    const int* HIST = (const int*)(ws + WS_HIST);
    if (F.tid < 64) { int acc = 0;
#pragma unroll 8
        for (int w = 0; w < 128; ++w) { pre[w * 64 + F.tid] = acc; acc += HIST[w * 64 + F.tid]; }
        tot[F.tid] = acc; if (F.vcu == 0) ((int*)F.ctl)[CW_CNT + F.tid] = acc; }
    __syncthreads();
    (void)moe_tables(F, tot, pstart, tile_e);
    const bf16* H1B = (const bf16*)(ws + WS_H1B); bf16* XS = (bf16*)(ws + WS_XS); int* ROUTE = (int*)(ws + WS_ROUTE);
    const int gw = F.vcu * NWAVES + F.wave, NGW = F.G * NWAVES;
#pragma unroll 1
    for (int t0 = gw * 16; t0 < NTOK; t0 += NGW * 16) {
        int p1 = 0, p2 = 0;
        if (lane < 16) { int* rt = ROUTE + (size_t)(t0 + lane) * 8; const int e1 = rt[0], e2 = rt[1], w = (t0 + lane) >> 8;
            p1 = pstart[e1] + pre[w * 64 + e1] + rt[4]; p2 = pstart[e2] + pre[w * 64 + e2] + rt[5]; rt[6] = p1; rt[7] = p2; }
#pragma unroll 4
        for (int k = 0; k < 16; ++k) {
            const int q1 = __shfl(p1, k), q2 = __shfl(p2, k);
            const v4u* src = (const v4u*)(H1B + (size_t)(t0 + k) * DM) + lane; const v4u a = src[0], b = src[64];
            v4u* d1 = (v4u*)(XS + (size_t)q1 * DM) + lane; v4u* d2 = (v4u*)(XS + (size_t)q2 * DM) + lane;
            d1[0] = a; d1[64] = b; d2[0] = a; d2[64] = b;
        }
    }
}
__device__ __forceinline__ void p12_final(Frame& F, const Args& A, float* out) {
    unsigned char* ws = F.ws; const int lane = F.lane;
    const float* H1 = (const float*)(ws + WS_H1); const bf16* Y2 = (const bf16*)(ws + WS_Y2); const int* ROUTE = (const int*)(ws + WS_ROUTE);
    const int gw = F.vcu * NWAVES + F.wave, NGW = F.G * NWAVES;
    f32x4 gam[4], bet[4];
#pragma unroll
    for (int j = 0; j < 4; ++j) { gam[j] = ((const f32x4*)A.in[I_LN2G])[lane + 64 * j]; bet[j] = ((const f32x4*)A.in[I_LN2B])[lane + 64 * j]; }
    for (int m = gw; m < NTOK; m += NGW) {
        const int* rt = ROUTE + (size_t)m * 8; const float w1 = __int_as_float(rt[2]), w2 = __int_as_float(rt[3]); const int p1 = rt[6], p2 = rt[7];
        const f32x4* xr = (const f32x4*)(H1 + (size_t)m * DM) + lane; const v2u* y1 = (const v2u*)(Y2 + (size_t)p1 * DM) + lane; const v2u* y2 = (const v2u*)(Y2 + (size_t)p2 * DM) + lane;
        f32x4 v[4]; float s = 0.f;
#pragma unroll
        for (int j = 0; j < 4; ++j) { const f32x4 x = xr[64 * j]; const v2u a = y1[64 * j], b = y2[64 * j];
            v[j].x = x.x * DN_ALPHA + (w1 * bflo(a.x) + w2 * bflo(b.x)); v[j].y = x.y * DN_ALPHA + (w1 * bfhi(a.x) + w2 * bfhi(b.x));
            v[j].z = x.z * DN_ALPHA + (w1 * bflo(a.y) + w2 * bflo(b.y)); v[j].w = x.w * DN_ALPHA + (w1 * bfhi(a.y) + w2 * bfhi(b.y));
            s += (v[j].x + v[j].y) + (v[j].z + v[j].w); }
        const float mean = wave_sum(s) * (1.f / DM); float s2 = 0.f;
#pragma unroll
        for (int j = 0; j < 4; ++j) { v[j] = v[j] - mean; s2 += (v[j].x * v[j].x + v[j].y * v[j].y) + (v[j].z * v[j].z + v[j].w * v[j].w); }
        const float rstd = 1.0f / sqrtf(wave_sum(s2) * (1.f / DM) + LN_EPS);
        f32x4* o = (f32x4*)(out + (size_t)m * DM) + lane;
#pragma unroll
        for (int j = 0; j < 4; ++j) o[64 * j] = v[j] * rstd * gam[j] + bet[j];
    }
}

__global__ void __launch_bounds__(NWAVES * 64, 2) fwd(Args args) {
    extern __shared__ __attribute__((aligned(16))) unsigned char lds[];
    Frame F;
    F.lds = (LAS unsigned char*)lds;
    F.MISC = (volatile LAS unsigned*)(F.lds + MISC_OFF);
    F.tid = threadIdx.x; F.lane = F.tid & 63; F.wave = __builtin_amdgcn_readfirstlane(F.tid >> 6);
    F.G = gridDim.x; { const int bx = blockIdx.x; F.vcu = (F.G % 8 == 0) ? (bx % 8) * (F.G / 8) + bx / 8 : bx; }
    F.ws = args.ws; F.ctl = (gu32*)(args.ws + WS_CTL); F.in = nullptr;
    unsigned char* ws = args.ws;
    for (int u = F.tid; u < (LDS_BYTES - LDSCTL_OFF) / 4; u += NWAVES * 64) ((LAS unsigned*)(F.lds + LDSCTL_OFF))[u] = 0u;
    __syncthreads();
    XcdBarrier bar; bar.bar = (unsigned*)(F.ctl + CW_BAR); bar.x = 0; bar.st = nullptr;
    if (MK_N_LAUNCHES == 1) bar = xcd_barrier_post((unsigned*)(F.ctl + CW_BAR), F.MISC + 8);
#define GRID_BAR() do { if (MK_N_LAUNCHES == 1) xcd_barrier(bar); } while (0)
    const int lo = args.ph_lo, hi = args.ph_hi;
#ifndef PH_MASK
#define PH_MASK 0x1fff
#endif
#define IN(k) ((((PH_MASK) >> (k)) & 1) && lo <= (k) && (k) < hi)
#define BOTH(k) (IN(k) && IN((k) + 1))
#ifndef PROBE_REP_MASK
#define PROBE_REP_MASK 0
#endif
#define REPS(k) for (int rep_ = 0; rep_ < 1 + (((PROBE_REP_MASK) >> (k)) & 1); ++rep_)
    LAS unsigned char* ring = F.lds + RING_OFF;

    if (IN(0)) { _Pragma("unroll") REPS(0) { p0_prologue(F, args); __syncthreads(); } if (BOTH(0)) GRID_BAR(); }
    if (IN(1)) {
        pg8::Gemm g{(const bf16*)(ws + WS_XB), (const bf16*)(ws + WS_WINT), 1024, 1024, 1024}; pg8::StaticOrder S; S.init(NTOK, NPROJ, F.G, (int)blockIdx.x);
        EpiProj E{(bf16*)(ws + WS_Q), (bf16*)(ws + WS_KV), (bf16*)(ws + WS_SA), (bf16*)(ws + WS_MG), (bf16*)(ws + WS_G), (const float*)(ws + WS_SMALL + SM_BIASR)};
        _Pragma("unroll") REPS(1) { pg8::gemm_phase<EpiProj, pg8::StaticOrder, true, true>(ring, g, S, E); }
        if (BOTH(1)) GRID_BAR();
    }
    if (IN(2)) {
        REPS(2) {
        if (F.vcu < 32) { pg8::Gemm g{(const bf16*)(ws + WS_KV), (const bf16*)(ws + WS_W1CT), 1024, 2048, 2048}; ListOrder S{32, F.G, F.vcu, 1, 16};
          EpiF32Half<true> E{(float*)(ws + WS_HID), (const float*)(ws + WS_SMALL + SM_B1C)};
          pg8::gemm_phase<EpiF32Half<true>, ListOrder, true, true>(ring, g, S, E); }
        else expert_transposes(F, args, 32);
        { pg8::Gemm g{(const bf16*)(ws + WS_SA) + 128, (const bf16*)(ws + WS_BPT), 384, 256, 256}; ListOrder S{256, F.G, F.vcu, 1, 8};
          EpiF32Half<false> E{(float*)(ws + WS_E), nullptr};
          pg8::gemm_phase<EpiF32Half<false>, ListOrder, true, true>(ring, g, S, E); }
        }
        if (BOTH(2)) GRID_BAR();
    }
    if (IN(3)) { _Pragma("unroll") REPS(3) { p3_thin(F, args); } if (BOTH(3)) GRID_BAR(); }
    if (IN(4)) {
        REPS(4) {
        { int k384 = 384; asm volatile("" : "+s"(k384));
          pg8::Gemm g{(const bf16*)(ws + WS_SA), (const bf16*)(ws + WS_CT), 384, 384, k384}; ListOrder S{256, F.G, F.vcu, 1, 8};
          EpiS5Y E{(bf16*)(ws + WS_Z)};
          pg8::gemm_phase<EpiS5Y, ListOrder, true, true>(ring, g, S, E); }
        __syncthreads();
        p4_attention(F, args);
        __syncthreads(); }
        if (BOTH(4)) GRID_BAR();
    }
    if (IN(5)) {
        pg8::Gemm g{(const bf16*)(ws + WS_O), (const bf16*)(ws + WS_WAT), 512, 512, 512}; pg8::StaticOrder S; S.init(NTOK, 1024, F.G, (int)blockIdx.x);
        EpiYa E{(bf16*)(ws + WS_T), (const bf16*)(ws + WS_MG)};
        _Pragma("unroll") REPS(5) { pg8::gemm_phase<EpiYa, pg8::StaticOrder, true, true>(ring, g, S, E); }
        if (BOTH(5)) GRID_BAR();
    }
    if (IN(6)) {
        pg8::Gemm g{(const bf16*)(ws + WS_Z), (const bf16*)(ws + WS_WVGT), 512, 512, 512}; pg8::StaticOrder S; S.init(NTOK, 2048, F.G, (int)blockIdx.x);
        EpiYb E{(const bf16*)(ws + WS_T), (const bf16*)(ws + WS_MG), args.in[I_BGATE], (bf16*)(ws + WS_MIX)};
        REPS(6) { pg8::gemm_phase<EpiYb, pg8::StaticOrder, true, true>(ring, g, S, E); }
        if (BOTH(6)) GRID_BAR();
    }
    if (IN(7)) {
        pg8::Gemm g{(const bf16*)(ws + WS_MIX), (const bf16*)(ws + WS_WOT), 1024, 1024, 1024}; pg8::StaticOrder S; S.init(NTOK, 1024, F.G, (int)blockIdx.x);
        EpiOut E{args.in[I_X], (float*)(ws + WS_H1)};
        _Pragma("unroll") REPS(7) { pg8::gemm_phase<EpiOut, pg8::StaticOrder, true, true>(ring, g, S, E); }
        if (BOTH(7)) GRID_BAR();
    }
    if (IN(8)) {
        p8_ln(F, args);
        GRID_BAR();
        { pg8::Gemm g{(const bf16*)(ws + WS_H1B), (const bf16*)(ws + WS_WRT), 1024, 1024, 1024}; RouterOrder S{F.vcu};
          EpiRouter E{args.in[I_RBG], args.in[I_RBE], (int*)(ws + WS_ROUTE), (int*)(ws + WS_HIST)};
          REPS(8) { pg8::gemm_phase<EpiRouter, RouterOrder, false, true, true>(ring, g, S, E); } }
        if (BOTH(8)) GRID_BAR();
    }
    if (IN(9)) { REPS(9) { p9_scatter(F, args); __syncthreads(); } if (BOTH(9)) GRID_BAR(); }
    if (IN(10)) {
        LAS int* pstart = (LAS int*)(F.lds + LTAB_OFF); LAS unsigned char* tile_e = (LAS unsigned char*)(F.lds + LTAB_OFF + 512);
        const int ntiles = moe_tables(F, (const int*)F.ctl + CW_CNT, pstart, tile_e);
        pg8::Gemm g{(const bf16*)(ws + WS_XS), (const bf16*)(ws + WS_WGUT), 1024, 1024, 1024}; MoeOrder S{ntiles * 2, F.G, F.vcu, 2, tile_e};
        EpiMoe1 E{(bf16*)(ws + WS_HB)};
        _Pragma("unroll") REPS(10) { pg8::gemm_phase<EpiMoe1, MoeOrder, true, true>(ring, g, S, E); }
        if (BOTH(10)) GRID_BAR();
    }
    if (IN(11)) {
        LAS int* pstart = (LAS int*)(F.lds + LTAB_OFF); LAS unsigned char* tile_e = (LAS unsigned char*)(F.lds + LTAB_OFF + 512);
        const int ntiles = moe_tables(F, (const int*)F.ctl + CW_CNT, pstart, tile_e);
        int k256 = 256; asm volatile("" : "+s"(k256));
        pg8::Gemm g{(const bf16*)(ws + WS_HB), (const bf16*)(ws + WS_WDT), 256, 256, k256}; MoeOrder S{ntiles * 4, F.G, F.vcu, 4, tile_e};
        EpiMoe2 E{(bf16*)(ws + WS_Y2)};
        _Pragma("unroll") REPS(11) { pg8::gemm_phase<EpiMoe2, MoeOrder, true, true>(ring, g, S, E); }
        if (BOTH(11)) GRID_BAR();
    }
#ifdef PROBE_EXTRA_BARS
    if (IN(12)) { _Pragma("unroll 1") for (int xb = 0; xb < PROBE_EXTRA_BARS; ++xb) GRID_BAR(); }
#endif
    if (IN(12)) { _Pragma("unroll") REPS(12) { p12_final(F, args, args.out); } }
#undef IN
#undef BOTH
}

extern "C" void kernel_launch(void* const* d_in, const int* in_sizes, int n_in, void* d_out, int out_size, void* d_ws, size_t ws_size, hipStream_t stream) {
    static int grid = 0;
    if (grid == 0) {
        if (n_in != 33 || out_size != NTOK * DM || ws_size < WS_END) { fprintf(stderr, "kernel_launch: unexpected problem shape (n_in %d, out %d, ws %zu)\n", n_in, out_size, ws_size); grid = -1; return; }
        int dev = 0, cus = 0, per_cu = 0;
        if (hipGetDevice(&dev) != hipSuccess || hipDeviceGetAttribute(&cus, hipDeviceAttributeMultiprocessorCount, dev) != hipSuccess) { grid = -1; return; }
        if (hipFuncSetAttribute((const void*)fwd, hipFuncAttributeMaxDynamicSharedMemorySize, LDS_BYTES) != hipSuccess) { fprintf(stderr, "kernel_launch: hipFuncSetAttribute failed\n"); grid = -1; return; }
        if (hipOccupancyMaxActiveBlocksPerMultiprocessor(&per_cu, (const void*)fwd, NWAVES * 64, LDS_BYTES) != hipSuccess || per_cu < 1)
            fprintf(stderr, "kernel_launch: occupancy query reports %d workgroups per CU\n", per_cu);
        (void)hipGetLastError();
        grid = cus;
    }
    if (grid < 0) return;
    if (hipMemsetAsync((char*)d_ws + WS_CTL, 0, CTL_ZERO_BYTES, stream) != hipSuccess) return;
    Args a{};
    for (int i = 0; i < 33; ++i) a.in[i] = (const float*)d_in[i];
    a.out = (float*)d_out; a.ws = (unsigned char*)d_ws;
    if (MK_N_LAUNCHES == 1) { a.ph_lo = 0; a.ph_hi = N_PHASES; hipLaunchKernelGGL(fwd, dim3(grid), dim3(NWAVES * 64), LDS_BYTES, stream, a); }
    else for (int li = 0; li < N_PHASES; ++li) { a.ph_lo = li; a.ph_hi = li + 1; hipLaunchKernelGGL(fwd, dim3(grid), dim3(NWAVES * 64), LDS_BYTES, stream, a); }
}
```

```cpp
#include <hip/hip_runtime.h>
#include <cstdio>
#include <cstdint>
#include <cmath>
namespace pg8 {
#define PG8_LAS __attribute__((address_space(3)))
typedef unsigned short bf16_t;
typedef short bf16x8 __attribute__((ext_vector_type(8)));
typedef float f32x4 __attribute__((ext_vector_type(4)));
typedef unsigned u32x4 __attribute__((ext_vector_type(4)));
constexpr int BM = 256, BK = 64, HALF = 128, HTB = HALF * BK * 2  , STAGE_BYTES = 8 * HTB, NXCD = 8, WGM = 8;

__host__ __device__ __forceinline__ int lds_byte(int r, int c) { const int st = (r >> 4) * 2 + (c >> 5), rr = r & 15, cc = c & 31, ob = rr * 64 + cc * 2; return st * 1024 + (ob ^ (((ob >> 9) & 1) << 5)); }
__host__ __device__ __forceinline__ void stage_rc(int b, int& R, int& C) { const int st = b / 1024, sb = b % 1024, swz = sb ^ (((sb >> 9) & 1) << 5); R = (st >> 1) * 16 + swz / 64; C = (st & 1) * 32 + (swz % 64) / 2; }
__host__ __device__ __forceinline__ int perm32(int rho) { const int n = rho >> 4, i = rho & 15; return 8 * (i >> 2) + 4 * n + (i & 3); }

struct Unit { int pm, pn; };
struct Gemm { const bf16_t* A; const bf16_t* Bt; int lda, ldb, K; };

struct StaticOrder {
    int nM, nN, nwg, G, c;
    __host__ __device__ void init(int M, int N, int G_, int c_) { nM = M / BM; nN = N / BM; nwg = nM * nN; G = G_; c = c_; }
    __host__ __device__ bool next(int i, Unit& u) const {
        const long L = (long)i * G + c; if (L >= nwg) return false;
        int wgid = (int)L; { const int q = nwg / NXCD, r = nwg % NXCD, xcd = wgid % NXCD, off = wgid / NXCD; wgid = (xcd < r ? xcd * (q + 1) : r * (q + 1) + (xcd - r) * q) + off; }
        const int nig = WGM * nN, gid = wgid / nig, fm = gid * WGM, gsz = (nM - fm) < WGM ? (nM - fm) : WGM;
        u.pm = fm + ((wgid % nig) % gsz); u.pn = (wgid % nig) / gsz; return true;
    }
    __device__ __forceinline__ void a_ready(const Unit&) const {}
    __device__ __forceinline__ void done(const Unit&) const {}
};

__device__ __forceinline__ unsigned cvt_pk_bf16(float lo, float hi) { unsigned r; asm volatile("v_cvt_pk_bf16_f32 %0, %1, %2" : "=v"(r) : "v"(lo), "v"(hi)); return r; }

template <class Epi, class Sched, bool ALIGN_EPI = false, bool SP2 = false, bool KEEP_ACC = false>
__device__ __forceinline__ void gemm_phase(PG8_LAS unsigned char* lds, const Gemm g, const Sched& S, const Epi& E) {
    const int tid = threadIdx.x, wid = __builtin_amdgcn_readfirstlane(tid >> 6), lane = tid & 63, wr = wid >> 2, wc = wid & 3, fr = lane & 15, fq = lane >> 4;
    const int K = g.K, nt = K / BK;
    unsigned voffA[2], voffB[2];
#pragma unroll
    for (int i = 0; i < 2; ++i) { int R, C; stage_rc(tid * 16 + i * 8192, R, C); const int Rb = Epi::PERM ? ((R & ~31) + perm32(R & 31)) : R;
        voffA[i] = (unsigned)(R * g.lda + C) * 2u; voffB[i] = (unsigned)(Rb * g.ldb + C) * 2u; }
    const size_t kstep = (size_t)(BK * 2);
    const size_t hstepA = (size_t)HALF * g.lda * 2, hstepB = (size_t)HALF * g.ldb * 2;
    const size_t tstepA = 2 * hstepA, tstepB = 2 * hstepB;
    const unsigned ldsw = (unsigned)wid * 1024u;
    const int aoff = lds_byte(wr * 64 + fr, fq * 8), boff = lds_byte(wc * 32 + fr, fq * 8);
#define PG8_SA(b, h) (((b) * 2 + (h)) * HTB)
#define PG8_SB(b, h) ((4 + (b) * 2 + (h)) * HTB)
#define PG8_STAGE(bufoff, gbase, voff) do { _Pragma("unroll") for (int _i = 0; _i < 2; ++_i) \
        __builtin_amdgcn_global_load_lds((const unsigned*)((const char*)(gbase) + (voff)[_i]), (PG8_LAS unsigned*)(lds + (bufoff) + ldsw + _i * 8192), 16, 0, 0); } while (0)
#define PG8_LDA(dst, b, h) do { _Pragma("unroll") for (int m = 0; m < 4; ++m) _Pragma("unroll") for (int k = 0; k < 2; ++k) dst[m][k] = *(const PG8_LAS bf16x8*)(lds + PG8_SA(b, h) + aoff + m * 2048 + k * 1024); } while (0)
#define PG8_LDB(dst, b, h) do { _Pragma("unroll") for (int n = 0; n < 2; ++n) _Pragma("unroll") for (int k = 0; k < 2; ++k) dst[n][k] = *(const PG8_LAS bf16x8*)(lds + PG8_SB(b, h) + boff + n * 2048 + k * 1024); } while (0)
#define PG8_MMA(ai, bj, At, Bt) do { __builtin_amdgcn_s_setprio(1); _Pragma("unroll") for (int m = 0; m < 4; ++m) _Pragma("unroll") for (int n = 0; n < 2; ++n) _Pragma("unroll") for (int k = 0; k < 2; ++k) \
        acc[ai][bj][m][n] = __builtin_amdgcn_mfma_f32_16x16x32_bf16(Bt[n][k], At[m][k], acc[ai][bj][m][n], 0, 0, 0); __builtin_amdgcn_s_setprio(0); } while (0)
#define PG8_WAIT_V(n) asm volatile("s_waitcnt vmcnt(" #n ")" ::: "memory")
#define PG8_WAIT_L(n) asm volatile("s_waitcnt lgkmcnt(" #n ")" ::: "memory")
#define PG8_BAR __builtin_amdgcn_s_barrier()
#define PG8_SCHED __builtin_amdgcn_sched_barrier(0)
    Unit cur, nxt; int ui = 0;
    if (!S.next(0, cur)) return;
    f32x4 acc[2][2][4][2];
#pragma unroll
    for (int a = 0; a < 2; ++a)
#pragma unroll
        for (int b = 0; b < 2; ++b)
#pragma unroll
            for (int m = 0; m < 4; ++m)
#pragma unroll
                for (int n = 0; n < 2; ++n) acc[a][b][m][n] = (f32x4){0.f, 0.f, 0.f, 0.f};
    bf16x8 At[4][2], B0[2][2], B1[2][2];
    const char* cA = (const char*)g.A + (size_t)cur.pm * tstepA; const char* cB = (const char*)g.Bt + (size_t)cur.pn * tstepB;
    S.a_ready(cur);
    if constexpr (SP2) {
        PG8_STAGE(PG8_SB(0, 0), cB, voffB); PG8_STAGE(PG8_SB(0, 1), cB + hstepB, voffB); PG8_STAGE(PG8_SA(0, 0), cA, voffA); PG8_STAGE(PG8_SA(0, 1), cA + hstepA, voffA);
        if (wr == 1) PG8_BAR;
        PG8_WAIT_V(2); PG8_BAR;
        PG8_STAGE(PG8_SB(1, 0), cB + kstep, voffB); PG8_STAGE(PG8_SA(1, 0), cA + kstep, voffA); PG8_STAGE(PG8_SB(1, 1), cB + hstepB + kstep, voffB);
        PG8_WAIT_V(6); PG8_BAR;
    } else {
        PG8_STAGE(PG8_SB(0, 0), cB, voffB); PG8_STAGE(PG8_SA(0, 0), cA, voffA); PG8_STAGE(PG8_SB(0, 1), cB + hstepB, voffB); PG8_STAGE(PG8_SA(0, 1), cA + hstepA, voffA);
        if (wr == 1) PG8_BAR;
        PG8_WAIT_V(4); PG8_BAR;
        PG8_STAGE(PG8_SB(1, 0), cB + kstep, voffB); PG8_STAGE(PG8_SA(1, 0), cA + kstep, voffA); PG8_STAGE(PG8_SB(1, 1), cB + hstepB + kstep, voffB);
        PG8_WAIT_V(6); PG8_BAR;
    }
    for (;;) {
        const bool has_next = S.next(ui + 1, nxt);
        const char* nA = has_next ? (const char*)g.A + (size_t)nxt.pm * tstepA : cA; const char* nB = has_next ? (const char*)g.Bt + (size_t)nxt.pn * tstepB : cB;
        for (int t = 0; t < nt; t += 2) {
            const bool last = (t == nt - 2);
            const char* a1 = cA + (size_t)(t + 1) * kstep;
            const char* a2 = last ? nA : cA + (size_t)(t + 2) * kstep; const char* b2 = last ? nB : cB + (size_t)(t + 2) * kstep;
            const char* a3 = a2 + kstep; const char* b3 = b2 + kstep;
            if (last && has_next) S.a_ready(nxt);
            if constexpr (SP2) {
            PG8_LDB(B0, 0, 0); PG8_LDB(B1, 0, 1); PG8_SCHED; PG8_LDA(At, 0, 0); PG8_STAGE(PG8_SA(1, 1), a1 + hstepA, voffA);
            PG8_WAIT_V(8); PG8_WAIT_L(0); PG8_BAR; PG8_MMA(0, 0, At, B0); PG8_MMA(0, 1, At, B1); PG8_BAR; PG8_SCHED;
            PG8_LDA(At, 0, 1); PG8_STAGE(PG8_SB(0, 0), b2, voffB); PG8_STAGE(PG8_SB(0, 1), b2 + hstepB, voffB); PG8_STAGE(PG8_SA(0, 0), a2, voffA);
            PG8_WAIT_V(8); PG8_WAIT_L(0); PG8_BAR; PG8_MMA(1, 0, At, B0); PG8_MMA(1, 1, At, B1); PG8_BAR; PG8_SCHED;
            PG8_LDB(B0, 1, 0); PG8_LDB(B1, 1, 1); PG8_SCHED; PG8_LDA(At, 1, 0); PG8_STAGE(PG8_SA(0, 1), a2 + hstepA, voffA);
            PG8_WAIT_V(8); PG8_WAIT_L(0); PG8_BAR; PG8_MMA(0, 0, At, B0); PG8_MMA(0, 1, At, B1); PG8_BAR; PG8_SCHED;
            PG8_LDA(At, 1, 1); PG8_STAGE(PG8_SB(1, 0), b3, voffB); PG8_STAGE(PG8_SB(1, 1), b3 + hstepB, voffB); PG8_STAGE(PG8_SA(1, 0), a3, voffA);
            PG8_WAIT_V(8); PG8_WAIT_L(0); PG8_BAR; PG8_MMA(1, 0, At, B0); PG8_MMA(1, 1, At, B1); PG8_BAR; PG8_SCHED;
            } else {
            PG8_LDB(B0, 0, 0); PG8_SCHED; PG8_LDA(At, 0, 0); PG8_STAGE(PG8_SA(1, 1), a1 + hstepA, voffA);
            PG8_WAIT_L(8); PG8_BAR; PG8_WAIT_L(0); PG8_MMA(0, 0, At, B0); PG8_BAR; PG8_SCHED;
            PG8_LDB(B1, 0, 1); PG8_STAGE(PG8_SB(0, 0), b2, voffB);
            PG8_BAR; PG8_WAIT_L(0); PG8_MMA(0, 1, At, B1); PG8_BAR;
            PG8_LDA(At, 0, 1); PG8_STAGE(PG8_SA(0, 0), a2, voffA);
            PG8_BAR; PG8_WAIT_L(0); PG8_MMA(1, 0, At, B0); PG8_BAR; PG8_SCHED;
            PG8_STAGE(PG8_SB(0, 1), b2 + hstepB, voffB);
            PG8_WAIT_V(6); PG8_BAR; PG8_MMA(1, 1, At, B1); PG8_BAR;
            PG8_LDB(B0, 1, 0); PG8_SCHED; PG8_LDA(At, 1, 0); PG8_STAGE(PG8_SA(0, 1), a2 + hstepA, voffA);
            PG8_WAIT_L(8); PG8_BAR; PG8_WAIT_L(0); PG8_MMA(0, 0, At, B0); PG8_BAR; PG8_SCHED;
            PG8_LDB(B1, 1, 1); PG8_STAGE(PG8_SB(1, 0), b3, voffB);
            PG8_BAR; PG8_WAIT_L(0); PG8_MMA(0, 1, At, B1); PG8_BAR;
            PG8_LDA(At, 1, 1); PG8_STAGE(PG8_SA(1, 0), a3, voffA);
            PG8_BAR; PG8_WAIT_L(0); PG8_MMA(1, 0, At, B0); PG8_BAR; PG8_SCHED;
            PG8_STAGE(PG8_SB(1, 1), b3 + hstepB, voffB);
            PG8_WAIT_V(6); PG8_BAR; PG8_MMA(1, 1, At, B1); PG8_BAR;
            }
        }
        if constexpr (ALIGN_EPI) { if (wr == 0) PG8_BAR; }
        if constexpr (!Epi::AFTER_DRAIN) { E(acc, cur, wr, wc, fr, fq); S.done(cur); }
        if (!has_next) break;
        if constexpr (!KEEP_ACC) {
#pragma unroll
        for (int a = 0; a < 2; ++a)
#pragma unroll
            for (int b = 0; b < 2; ++b)
#pragma unroll
                for (int m = 0; m < 4; ++m)
#pragma unroll
                    for (int n = 0; n < 2; ++n) acc[a][b][m][n] = (f32x4){0.f, 0.f, 0.f, 0.f};
        }
        cur = nxt; cA = nA; cB = nB; ++ui;
        if constexpr (ALIGN_EPI) { if (wr == 1) PG8_BAR; }
    }
    PG8_WAIT_V(0);
    if constexpr (!ALIGN_EPI) { if (wr == 0) PG8_BAR; }
    PG8_BAR;
    if constexpr (Epi::AFTER_DRAIN) { E.fused(acc, cur, wr, wc, fr, fq, lds, wid, lane); S.done(cur); }
#undef PG8_SA
#undef PG8_SB
#undef PG8_STAGE
#undef PG8_LDA
#undef PG8_LDB
#undef PG8_MMA
#undef PG8_WAIT_V
#undef PG8_WAIT_L
#undef PG8_BAR
#undef PG8_SCHED
}
}

constexpr int NWAVES = 8;
#ifndef MK_N_LAUNCHES
#define MK_N_LAUNCHES 1
#endif
constexpr int N_PHASES = 13;
constexpr int DM = 1024, NB = 8, SEQ = 4096, NTOK = NB * SEQ;
constexpr int NPROJ = 4096;
constexpr int D_IN = 3864;
constexpr int MOE_CAP = 2 * NTOK + 64 * 256;
constexpr float LN_EPS = 1e-5f;
constexpr float DN_ALPHA = 1.189207115002721f;

constexpr size_t MiB = 1u << 20;
constexpr size_t WS_CTL = 0, CTL_ZERO_BYTES = 64 * 1024;
constexpr size_t WS_SMALL = 1 * MiB;
constexpr size_t WS_WAT = 2 * MiB, WS_WVGT = 3 * MiB, WS_WOT = 5 * MiB, WS_W1CT = 7 * MiB, WS_BPT = 9 * MiB, WS_CT = 13 * MiB;
constexpr size_t WS_ROUTE = 19 * MiB;
constexpr size_t WS_HIST = 1 * MiB + 128 * 1024;
constexpr size_t WS_KC = 20 * MiB;
constexpr size_t WS_HID = 21 * MiB;
constexpr size_t WS_WRT = 25 * MiB;
constexpr size_t WS_WGUT = 26 * MiB, WS_WDT = 90 * MiB;
constexpr size_t WS_MG = 122 * MiB;
constexpr size_t WS_H1 = WS_MG;
constexpr size_t WS_XB = 250 * MiB;
constexpr size_t WS_Z = 250 * MiB, WS_O = 282 * MiB, WS_H1B = 250 * MiB, WS_HB = 250 * MiB;
constexpr size_t WS_Q = 314 * MiB, WS_KV = 346 * MiB, WS_SA = 394 * MiB, WS_G = 442 * MiB, WS_WINT = 444 * MiB, WS_E = 452 * MiB;
constexpr size_t WS_HLO = 314 * MiB;
constexpr size_t WS_T = 314 * MiB;
constexpr size_t WS_MIX = 394 * MiB;
constexpr size_t WS_XS = 314 * MiB, WS_Y2 = 314 * MiB;
constexpr size_t WS_END = 512 * MiB;
static_assert(WS_XS + (size_t)MOE_CAP * 1024 * 2 <= WS_END && WS_HB + (size_t)MOE_CAP * 256 * 2 <= WS_XS, "d_ws map");
constexpr size_t SM_BIASR = 0;
constexpr size_t SM_B1C = 32 * 1024;
constexpr size_t SM_LUT = 40 * 1024;
constexpr size_t SM_A16 = 48 * 1024;
constexpr int CW_CNT = 64, CW_CUR = 128;
constexpr int CW_BAR = 4096;

constexpr int RING_OFF = 0, RING_BYTES = 131072;
constexpr int LDSCTL_OFF = RING_BYTES, MISC_OFF = LDSCTL_OFF + 320;
constexpr int LTAB_OFF = LDSCTL_OFF + 1024;
constexpr int LDS_BYTES = 147456;

#define GAS __attribute__((address_space(1)))
#define LAS __attribute__((address_space(3)))
typedef unsigned short bf16;
typedef unsigned v4u __attribute__((ext_vector_type(4)));
typedef unsigned v2u __attribute__((ext_vector_type(2)));
typedef float f32x4 __attribute__((ext_vector_type(4)));
typedef float f32x2 __attribute__((ext_vector_type(2)));
typedef GAS unsigned gu32;
#define RLX_AGENT __ATOMIC_RELAXED, __HIP_MEMORY_SCOPE_AGENT
#define LDS_WAIT() asm volatile("s_waitcnt lgkmcnt(0)" ::: "memory")
#define VM_WAIT() asm volatile("s_waitcnt vmcnt(0)" ::: "memory")
typedef __bf16 bf16x2_t __attribute__((ext_vector_type(2)));
__device__ __forceinline__ unsigned pk2(float lo, float hi) { const f32x2 v = {lo, hi}; const bf16x2_t b = __builtin_convertvector(v, bf16x2_t); return __builtin_bit_cast(unsigned, b); }
__device__ __forceinline__ float bflo(unsigned w) { return __uint_as_float(w << 16); }
__device__ __forceinline__ float bfhi(unsigned w) { return __uint_as_float(w & 0xffff0000u); }
__device__ __forceinline__ float bf2f(bf16 h) { return __uint_as_float(((unsigned)h) << 16); }
__device__ __forceinline__ float sigmoidf_(float x) { return __builtin_amdgcn_rcpf(1.0f + __expf(-x)); }
__device__ __forceinline__ float gelu_tanh(float x) { const float z2 = x * (1.5957691216057308f + 0.07135481627260025f * x * x); return x * __builtin_amdgcn_rcpf(1.0f + __expf(-z2)); }
__device__ __forceinline__ float wave_sum(float v) {
#pragma unroll
    for (int o = 1; o < 64; o <<= 1) v += __shfl_xor(v, o);
    return v;
}
__device__ __forceinline__ float wave_max(float v) {
#pragma unroll
    for (int o = 1; o < 64; o <<= 1) v = fmaxf(v, __shfl_xor(v, o));
    return v;
}

#define XB_TMO      128
#define XB_XCNT(j)  (256  + 64 * (j))
#define XB_XSUB(j)  (1280 + 64 * (j))
#define XB_XGEN(j)  (2304 + 64 * (j))
#define XB_TOP      3328
#define XB_TOPGEN   3392
#define XCD_BAR_WORDS 3456
#define XB_SPIN_CAP (1u << 18)

__device__ __forceinline__ unsigned xb_ld(unsigned* p)              { return __hip_atomic_load(p, __ATOMIC_RELAXED, __HIP_MEMORY_SCOPE_AGENT); }
__device__ __forceinline__ unsigned xb_add(unsigned* p, unsigned v) { return __hip_atomic_fetch_add(p, v, __ATOMIC_RELAXED, __HIP_MEMORY_SCOPE_AGENT); }
__device__ __forceinline__ unsigned xb_xcc_id() { return (unsigned)__builtin_amdgcn_s_getreg((3 << 11) | 20) & 0xFu; }
#define XB_SPIN(cond, bar) do { unsigned _sp = 0; while (cond) { __builtin_amdgcn_s_sleep(1); \
    if ((++_sp & 255u) == 0u) { if (xb_ld(&(bar)[XB_TMO])) break; if (_sp > XB_SPIN_CAP) { atomicAdd(&(bar)[XB_TMO], 1u); break; } } } } while (0)

struct XcdBarrier {
    unsigned* bar; unsigned x;
    volatile LAS unsigned* st;
};

__device__ __forceinline__ XcdBarrier xcd_barrier_post(unsigned* bar, volatile LAS unsigned* st) {
    XcdBarrier b; b.bar = bar; b.x = xb_xcc_id(); b.st = st;
    if (threadIdx.x == 0) (void)xb_add(&bar[XB_XCNT(b.x)], 1u);
    return b;
}
__device__ __forceinline__ void xcd_barrier_complete(unsigned* bar, unsigned x, unsigned& nloc, unsigned& nx) {
    const unsigned G = gridDim.x * gridDim.y * gridDim.z;
    unsigned sum, cnt, mine, sp = 0u;
    for (;;) {
        sum = 0u; cnt = 0u; mine = 0u;
#pragma unroll
        for (unsigned j = 0; j < 16; ++j) { const unsigned c = xb_ld(&bar[XB_XCNT(j)]); sum += c; cnt += (c > 0u) ? 1u : 0u; mine = (j == x) ? c : mine; }
        if (sum == G) break;
        __builtin_amdgcn_s_sleep(1);
        if ((++sp & 255u) == 0u) { if (xb_ld(&bar[XB_TMO])) break; if (sp > XB_SPIN_CAP) { atomicAdd(&bar[XB_TMO], 1u); break; } }
    }
    nloc = mine > 0u ? mine : 1u; nx = cnt > 0u ? cnt : 1u;
}

__device__ __forceinline__ void xcd_barrier(const XcdBarrier& b) {
    asm volatile("s_waitcnt vmcnt(0)" ::: "memory");
    __syncthreads();
    if (threadIdx.x == 0) {
        unsigned* bar = b.bar;
        __builtin_amdgcn_s_waitcnt(0);
        unsigned nloc = b.st[0], nx = b.st[1];
        if (nloc == 0u) { xcd_barrier_complete(bar, b.x, nloc, nx); b.st[0] = nloc; b.st[1] = nx; }
        const unsigned old = xb_add(&bar[XB_XSUB(b.x)], 1u);
        const unsigned gen = old / nloc;
        if (old + 1u == (gen + 1u) * nloc) {
            __builtin_amdgcn_fence(__ATOMIC_RELEASE, "agent");
            asm volatile("s_waitcnt vmcnt(0)" ::: "memory");
            const unsigned og = xb_add(&bar[XB_TOP], 1u);
            const unsigned tg = og / nx;
            if (og + 1u == (tg + 1u) * nx) xb_add(&bar[XB_TOPGEN], 1u);
            else XB_SPIN(xb_ld(&bar[XB_TOPGEN]) == tg, bar);
            __builtin_amdgcn_fence(__ATOMIC_ACQUIRE, "agent");
            xb_add(&bar[XB_XGEN(b.x)], 1u);
            asm volatile("s_waitcnt vmcnt(0)" ::: "memory");
        } else {
            XB_SPIN(xb_ld(&bar[XB_XGEN(b.x)]) == gen, bar);
            __builtin_amdgcn_fence(__ATOMIC_ACQUIRE, "agent");
            asm volatile("s_waitcnt vmcnt(0)" ::: "memory");
        }
    }
    __syncthreads();
}

struct Frame {
    LAS unsigned char* lds;
    volatile LAS unsigned* MISC;
    gu32* ctl;
    int tid, lane, wave, vcu, G;
    const float* const* in;
    unsigned char* ws;
};
struct Args { const float* in[33]; float* out; unsigned char* ws; int ph_lo, ph_hi; };
enum { I_X = 0, I_RELB, I_WIN, I_BIN, I_CPOS, I_CW1, I_CB1, I_CW2, I_CB2, I_WATT, I_LRE, I_LIM, I_LDT, I_BRE, I_BIM, I_CRE, I_CIM, I_SD, I_WVAL, I_WGATE, I_BGATE, I_WOUT,
       I_LN1G, I_LN1B, I_RWG, I_RBG, I_RWE, I_RBE, I_EWG, I_EWU, I_EWD, I_LN2G, I_LN2B };

struct TrItem { const float* colp; int ldw, k0, K; bf16* wt; };
__device__ __forceinline__ void tr_load(const TrItem& t, float (&tv)[32], int lane) {
#pragma unroll
    for (int i = 0; i < 32; ++i) { const int kk = 2 * i + (lane >> 5); tv[i] = t.colp ? t.colp[(size_t)(t.k0 + kk) * t.ldw] : 0.f; }
}
__device__ __forceinline__ void tr_store(const TrItem& t, const float (&tv)[32], LAS float* scr, int lane) {
#pragma unroll
    for (int i = 0; i < 32; ++i) { const int kk = 2 * i + (lane >> 5); scr[kk * 33 + (lane & 31)] = tv[i]; }
    LDS_WAIT(); asm volatile("" ::: "memory");
    const int c = lane & 7;
#pragma unroll
    for (int j = 0; j < 4; ++j) { const int n = (lane >> 3) + 8 * j; const LAS float* s = scr + (8 * c) * 33 + n;
        v4u o; o.x = pk2(s[0 * 33], s[1 * 33]); o.y = pk2(s[2 * 33], s[3 * 33]); o.z = pk2(s[4 * 33], s[5 * 33]); o.w = pk2(s[6 * 33], s[7 * 33]);
        *(v4u*)(t.wt + (size_t)n * t.K + 8 * c) = o; }
    LDS_WAIT(); asm volatile("" ::: "memory");
}
__device__ __forceinline__ void tr_item(const float* colp, int ldw, int k0, bf16* wt_row0  , int K, LAS float* scr, int lane) {
    const TrItem t{colp, ldw, k0, K, wt_row0}; float tv[32]; tr_load(t, tv, lane); tr_store(t, tv, scr, lane);
}
__device__ __forceinline__ int proj_src_col(int n) {
    return n < 1280 ? n : (n < 3840 ? n + 24 : (n < 3864 ? n - 3840 + 1280 : -1));
}
__device__ __forceinline__ int t5_bucket(int n) {
    if (n < 16) return n;
    const float nf = (float)n;
    int large = 16 + (int)(logf(nf / 16.0f) / 2.0794415416798357f * 16.0f);
    return large < 31 ? large : 31;
}
__device__ __forceinline__ void p0_prologue(Frame& F, const Args& A) {
    unsigned char* ws = F.ws;
    const int gw = F.vcu * NWAVES + F.wave, NGW = F.G * NWAVES, lane = F.lane;
    if (F.vcu < 32) {
        const int g = F.vcu, tid = F.tid;
        LAS float* pwr = (LAS float*)(F.lds);
        LAS float* pwi = pwr + 17 * 64;
        LAS float* bbr = pwi + 17 * 64;
        LAS float* bbi = bbr + 1024;
        LAS float* ccr = bbi + 1024;
        LAS float* cci = ccr + 1024;
        LAS float* kk  = cci + 1024;
        LAS float* fre = kk + 4096;
        if (tid < 64) {
            const int p = tid; const float lr = A.in[I_LRE][g * 64 + p], li = A.in[I_LIM][g * 64 + p], dt = expf(A.in[I_LDT][g]);
            for (int k = 0; k <= 16; ++k) { const float mag = expf((float)k * lr * dt), ang = (float)k * li * dt; pwr[k * 64 + p] = mag * cosf(ang); pwi[k * 64 + p] = mag * sinf(ang); }
            const float mag = expf(lr * dt), abr = mag * cosf(li * dt), abi = mag * sinf(li * dt), nr = abr - 1.0f, ni = abi, den = lr * lr + li * li;
            fre[p] = (nr * lr + ni * li) / den; fre[64 + p] = (ni * lr - nr * li) / den;
            float* a16 = (float*)(ws + WS_SMALL + SM_A16) + (size_t)(g * 64 + p) * 2; a16[0] = pwr[16 * 64 + p]; a16[1] = pwi[16 * 64 + p];
        }
        __syncthreads();
        for (int e = tid; e < 1024; e += 512) { const int p = e >> 4; const float br = A.in[I_BRE][g * 1024 + e], bi = A.in[I_BIM][g * 1024 + e], fr = fre[p], fi = fre[64 + p];
            bbr[e] = fr * br - fi * bi; bbi[e] = fr * bi + fi * br; ccr[e] = A.in[I_CRE][g * 1024 + e]; cci[e] = A.in[I_CIM][g * 1024 + e]; }
        __syncthreads();
        for (int e = tid; e < 4096; e += 512) { const int d = e >> 8, h = (e >> 4) & 15, h2 = e & 15; float s = 0.f;
            for (int p = 0; p < 64; ++p) { const float cr = ccr[h * 64 + p], ci = cci[h * 64 + p], ar = pwr[d * 64 + p], ai = pwi[d * 64 + p], br = bbr[p * 16 + h2], bi = bbi[p * 16 + h2];
                const float tr = cr * ar - ci * ai, ti = cr * ai + ci * ar; s += tr * br - ti * bi; }
            if (d == 0 && h == h2) s += A.in[I_SD][g * 16 + h];
            kk[e] = s; }
        __syncthreads();
        bf16* CT = (bf16*)(ws + WS_CT) + (size_t)g * 256 * 384;
        for (int v = tid; v < 256 * 48; v += 512) { const int n = v / 48, k0 = (v % 48) * 8, tau = n >> 4, h = n & 15; float o[8];
#pragma unroll
            for (int i = 0; i < 8; ++i) { const int k = k0 + i;
                if (k < 128) { const int p = k & 63; const float cr = ccr[h * 64 + p], ci = cci[h * 64 + p], ar = pwr[(tau + 1) * 64 + p], ai = pwi[(tau + 1) * 64 + p];
                    o[i] = (k < 64) ? (cr * ar - ci * ai) : -(cr * ai + ci * ar); }
                else { const int s = (k - 128) >> 4, h2 = (k - 128) & 15; o[i] = (s <= tau) ? kk[((tau - s) << 8) + (h << 4) + h2] : 0.f; } }
            v4u w; w.x = pk2(o[0], o[1]); w.y = pk2(o[2], o[3]); w.z = pk2(o[4], o[5]); w.w = pk2(o[6], o[7]);
            *(v4u*)(CT + (size_t)n * 384 + k0) = w; }
        bf16* BPT = (bf16*)(ws + WS_BPT) + (size_t)g * 256 * 256;
        for (int v = tid; v < 256 * 32; v += 512) { const int n = v >> 5, k0 = (v & 31) * 8; float o[8];
#pragma unroll
            for (int i = 0; i < 8; ++i) { const int k = k0 + i, s = k >> 4, h2 = k & 15;
                if (n < 128) { const int p = n & 63; const float ar = pwr[(15 - s) * 64 + p], ai = pwi[(15 - s) * 64 + p], br = bbr[p * 16 + h2], bi = bbi[p * 16 + h2];
                    o[i] = (n < 64) ? (ar * br - ai * bi) : (ar * bi + ai * br); }
                else o[i] = 0.f; }
            v4u w; w.x = pk2(o[0], o[1]); w.y = pk2(o[2], o[3]); w.z = pk2(o[4], o[5]); w.w = pk2(o[6], o[7]);
            *(v4u*)(BPT + (size_t)n * 256 + k0) = w; }
        __syncthreads();
    }
    {
        const int gt = F.vcu * (NWAVES * 64) + F.tid;
        float* biasr = (float*)(ws + WS_SMALL + SM_BIASR);
        if (gt < NPROJ) { const int sc = proj_src_col(gt); biasr[gt] = sc >= 0 ? A.in[I_BIN][sc] : 0.f; }
        float* lut = (float*)(ws + WS_SMALL + SM_LUT);
        if (gt >= 8192 && gt < 8192 + 1024) { const int e = gt - 8192, dist = e >> 3, h = e & 7; lut[e] = A.in[I_RELB][t5_bucket(dist) * 8 + h]; }
        bf16* wr = (bf16*)(ws + WS_WRT);
        for (int e = gt; e < 512 * 1024; e += F.G * NWAVES * 64) { const int r = e >> 10, k = e & 1023; int n = -1, lo = 0;
            if (r < 72) n = r; else if (r >= 128 && r < 200) { n = r - 128; lo = 1; } else if (r >= 256 && r < 328) n = r - 256;
            float o = 0.f;
            if (n >= 0) { const float w = n < 8 ? A.in[I_RWG][k * 8 + n] : A.in[I_RWE][k * 64 + (n - 8)]; const float hi = __uint_as_float(pk2(w, 0.f) << 16); o = lo ? w - hi : w; }
            wr[e] = (bf16)(pk2(o, 0.f) & 0xffffu); }
        if (gw >= 1024 && gw < 1024 + 256) { const int o = gw - 1024, j = o >> 7, c = o & 127; float s = 0.f;
            for (int i = lane; i < 2048; i += 64) s += A.in[I_CPOS][j * 2048 + i] * A.in[I_CW1][((size_t)j * 2048 + i) * 128 + c];
            s = wave_sum(s); if (lane == 0) ((float*)(ws + WS_SMALL + SM_B1C))[o] = s + A.in[I_CB1][o]; }
    }
    {
        LAS float* scr = (LAS float*)(F.lds + RING_OFF + 32768 + F.wave * 8704);
        constexpr int I_WI = 16 * 128, I_WA = 8 * 32, I_WV = 8 * 64, I_WO = 16 * 32, I_W1 = 2 * 32 * 8;
        constexpr int NITEMS = I_WI + I_WA + I_WV + I_WO + I_W1;
        const int nl = lane & 31;
        for (int it = gw; it < NITEMS; it += NGW) {
            int r = it;
            if (r < I_WI) { const int kb = r / 128, nb = r % 128, n = nb * 32 + nl, sc = proj_src_col(n);
                tr_item(sc >= 0 ? A.in[I_WIN] + sc : nullptr, D_IN, kb * 64, (bf16*)(ws + WS_WINT) + (size_t)(nb * 32) * 1024 + kb * 64, 1024, scr, lane); continue; } r -= I_WI;
            if (r < I_WA) { const int kb = r / 32, nb = r % 32, n = nb * 32 + nl;
                tr_item(A.in[I_WATT] + n, 1024, kb * 64, (bf16*)(ws + WS_WAT) + (size_t)(nb * 32) * 512 + kb * 64, 512, scr, lane); continue; } r -= I_WA;
            if (r < I_WV) { const int kb = r / 64, nb = r % 64, n = nb * 32 + nl, pn = n >> 8, rr = n & 255;
                const float* src = (rr < 128 ? A.in[I_WVAL] : A.in[I_WGATE]) + pn * 128 + (rr & 127);
                tr_item(src, 1024, kb * 64, (bf16*)(ws + WS_WVGT) + (size_t)(nb * 32) * 512 + kb * 64, 512, scr, lane); continue; } r -= I_WV;
            if (r < I_WO) { const int kb = r / 32, nb = r % 32, n = nb * 32 + nl;
                tr_item(A.in[I_WOUT] + n, 1024, kb * 64, (bf16*)(ws + WS_WOT) + (size_t)(nb * 32) * 1024 + kb * 64, 1024, scr, lane); continue; } r -= I_WO;
            if (r < I_W1) { const int j = r / 256, q = r % 256, kb = q / 8, nb = q % 8, n = nb * 32 + nl;
                tr_item(n < 128 ? A.in[I_CW1] + (size_t)j * 2048 * 128 + n : nullptr, 128, kb * 64, (bf16*)(ws + WS_W1CT) + ((size_t)j * 256 + nb * 32) * 2048 + kb * 64, 2048, scr, lane); }
        }
    }
#pragma unroll 2
    for (int m = gw; m < NTOK; m += NGW) {
        const f32x4* xr = (const f32x4*)(A.in[I_X] + (size_t)m * DM) + lane; v2u* o8 = (v2u*)((bf16*)(ws + WS_XB) + (size_t)m * DM) + lane;
#pragma unroll
        for (int j = 0; j < 4; ++j) { const f32x4 v = xr[64 * j]; v2u w; w.x = pk2(v.x, v.y); w.y = pk2(v.z, v.w); o8[64 * j] = w; }
    }
}

__device__ __forceinline__ TrItem expert_item(const Args& A, unsigned char* ws, int r, int nl) {
    constexpr int I_GU = 64 * 256;
    if (r < I_GU) { const int e = r / 256, q = r % 256, kb = q / 16, nb = q % 16, n = nb * 32 + nl, pn = n >> 8, rr = n & 255;
        const float* src = (rr < 128 ? A.in[I_EWG] : A.in[I_EWU]) + (size_t)e * 1024 * 256 + pn * 128 + (rr & 127);
        return TrItem{src, 256, kb * 64, 1024, (bf16*)(ws + WS_WGUT) + ((size_t)e * 512 + nb * 32) * 1024 + kb * 64}; }
    r -= I_GU;
    const int e = r / 128, q = r % 128, kb = q / 32, nb = q % 32, n = nb * 32 + nl;
    return TrItem{A.in[I_EWD] + (size_t)e * 256 * 1024 + n, 1024, kb * 64, 256, (bf16*)(ws + WS_WDT) + ((size_t)e * 1024 + nb * 32) * 256 + kb * 64};
}
__device__ __forceinline__ void expert_transposes(Frame& F, const Args& A, int wg0) {
    unsigned char* ws = F.ws; const int lane = F.lane, nl = lane & 31;
    LAS float* scr = (LAS float*)(F.lds + RING_OFF + F.wave * 8704);
    constexpr int NIT = 64 * 256 + 64 * 128;
    const int gw = (F.vcu - wg0) * NWAVES + F.wave, NGW = (F.G - wg0) * NWAVES;
    float ta[32], tb[32];
    int it = gw;
    if (it < NIT) { TrItem cur = expert_item(A, ws, it, nl); tr_load(cur, ta, lane);
#pragma unroll 1
        for (;;) {
            const int it2 = it + NGW; TrItem nxt = cur;
            if (it2 < NIT) { nxt = expert_item(A, ws, it2, nl); tr_load(nxt, tb, lane); }
            tr_store(cur, ta, scr, lane);
            if (it2 >= NIT) break;
            const int it3 = it2 + NGW; cur = nxt;
            if (it3 < NIT) { cur = expert_item(A, ws, it3, nl); tr_load(cur, ta, lane); }
            tr_store(nxt, tb, scr, lane);
            if (it3 >= NIT) break;
            it = it3;
        }
    }
    __syncthreads();
}

typedef pg8::f32x4 (AccT)[2][2][4][2];
constexpr float QSCALE = 0.125f * 1.4426950408889634f;
struct EpiProj {
    static constexpr bool PERM = true, AFTER_DRAIN = false;
    bf16 *Q, *KV, *SA, *MG, *G; const float* bias;
    __device__ __forceinline__ void operator()(const AccT& acc, const pg8::Unit& u, int wr, int wc, int fr, int fq) const {
        const int pn = u.pn, row0 = u.pm * 256 + wr * 64 + fr;
#pragma unroll
        for (int bj = 0; bj < 2; ++bj) {
            const int cl = bj * 128 + wc * 32 + 8 * fq, nc = pn * 256 + cl;
            const f32x4 b0 = *(const f32x4*)(bias + nc), b1 = *(const f32x4*)(bias + nc + 4);
#pragma unroll
            for (int ai = 0; ai < 2; ++ai)
#pragma unroll
                for (int m = 0; m < 4; ++m) {
                    const int row = row0 + ai * 128 + m * 16;
                    f32x4 v0 = acc[ai][bj][m][0] + b0, v1 = acc[ai][bj][m][1] + b1;
                    bf16* dst;
                    if (pn < 2) { v0 = v0 * QSCALE; v1 = v1 * QSCALE; dst = Q + (size_t)row * 512 + nc; }
                    else if (pn < 5) { const int kc = nc - 512, j = kc >> 7, g = (kc >> 6) & 1, d = kc & 63, b = row >> 12, t = row & 4095; dst = KV + ((((size_t)j * 8 + b) * 2 + g) * 4096 + t) * 64 + d; }
                    else if (pn < 7) { const int uc = nc - 1280, grp = uc >> 4, h = uc & 15, b = row >> 12, t = row & 4095; dst = SA + ((size_t)grp * 2048 + b * 256 + (t >> 4)) * 384 + 128 + (t & 15) * 16 + h; }
                    else {
                        v0.x = sigmoidf_(v0.x); v0.y = sigmoidf_(v0.y); v0.z = sigmoidf_(v0.z); v0.w = sigmoidf_(v0.w);
                        v1.x = sigmoidf_(v1.x); v1.y = sigmoidf_(v1.y); v1.z = sigmoidf_(v1.z); v1.w = sigmoidf_(v1.w);
                        if (pn < 15) dst = MG + (size_t)row * 2048 + (nc - 1792);
                        else { if (cl >= 24) continue; dst = G + (size_t)row * 32 + cl; }
                    }
                    v4u w; w.x = pk2(v0.x, v0.y); w.y = pk2(v0.z, v0.w); w.z = pk2(v1.x, v1.y); w.w = pk2(v1.z, v1.w);
                    *(v4u*)dst = w;
                }
        }
    }
};
template <bool GELU> struct EpiF32Half {
    static constexpr bool PERM = false, AFTER_DRAIN = false;
    float* O; const float* bias;
    __device__ __forceinline__ void operator()(const AccT& acc, const pg8::Unit& u, int wr, int wc, int fr, int fq) const {
        const int row0 = u.pm * 256 + wr * 64 + fr;
#pragma unroll
        for (int n = 0; n < 2; ++n) {
            const int c = wc * 32 + 16 * n + 4 * fq;
            f32x4 bv = (f32x4){0.f, 0.f, 0.f, 0.f}; if (bias) bv = *(const f32x4*)(bias + u.pn * 128 + c);
#pragma unroll
            for (int ai = 0; ai < 2; ++ai)
#pragma unroll
                for (int m = 0; m < 4; ++m) { f32x4 v = acc[ai][0][m][n] + bv;
                    if (GELU) { v.x = gelu_tanh(v.x); v.y = gelu_tanh(v.y); v.z = gelu_tanh(v.z); v.w = gelu_tanh(v.w); }
                    *(f32x4*)(O + (size_t)(row0 + ai * 128 + m * 16) * 128 + c) = v; }
        }
    }
};
struct EpiS5Y {
    static constexpr bool PERM = true, AFTER_DRAIN = false;
    bf16* Z;
    __device__ __forceinline__ void operator()(const AccT& acc, const pg8::Unit& u, int wr, int wc, int fr, int fq) const {
        const int g = u.pn, b = u.pm & 7, ch0 = wr * 64 + fr;
#pragma unroll
        for (int bj = 0; bj < 2; ++bj) { const int n0 = bj * 128 + wc * 32 + 8 * fq, tau = n0 >> 4, h = n0 & 15;
            bf16* zp = Z + ((size_t)b * 4096 + ch0 * 16 + tau) * 512 + g * 16 + h;
#pragma unroll
            for (int ai = 0; ai < 2; ++ai)
#pragma unroll
                for (int m = 0; m < 4; ++m) {
                    const f32x4 v0 = acc[ai][bj][m][0], v1 = acc[ai][bj][m][1];
                    v4u w; w.x = pk2(gelu_tanh(v0.x), gelu_tanh(v0.y)); w.y = pk2(gelu_tanh(v0.z), gelu_tanh(v0.w)); w.z = pk2(gelu_tanh(v1.x), gelu_tanh(v1.y)); w.w = pk2(gelu_tanh(v1.z), gelu_tanh(v1.w));
                    *(v4u*)(zp + (size_t)(ai * 128 + m * 16) * 16 * 512) = w; asm volatile("" ::: "memory"); } }
    }
};
struct EpiYa {
    static constexpr bool PERM = true, AFTER_DRAIN = false;
    bf16* T; const bf16* MG;
    __device__ __forceinline__ void operator()(const AccT& acc, const pg8::Unit& u, int wr, int wc, int fr, int fq) const {
        const int row0 = u.pm * 256 + wr * 64 + fr;
#pragma unroll
        for (int bj = 0; bj < 2; ++bj) { const int col = u.pn * 256 + bj * 128 + wc * 32 + 8 * fq;
#pragma unroll
            for (int ai = 0; ai < 2; ++ai)
#pragma unroll
                for (int m = 0; m < 4; ++m) { const int row = row0 + ai * 128 + m * 16;
                    const v4u g = *(const v4u*)(MG + (size_t)row * 2048 + col); const f32x4 v0 = acc[ai][bj][m][0], v1 = acc[ai][bj][m][1];
                    v4u w; w.x = pk2(v0.x * bflo(g.x), v0.y * bfhi(g.x)); w.y = pk2(v0.z * bflo(g.y), v0.w * bfhi(g.y)); w.z = pk2(v1.x * bflo(g.z), v1.y * bfhi(g.z)); w.w = pk2(v1.z * bflo(g.w), v1.w * bfhi(g.w));
                    *(v4u*)(T + (size_t)row * 1024 + col) = w; } }
    }
};
struct EpiYb {
    static constexpr bool PERM = true, AFTER_DRAIN = false;
    const bf16* T; const bf16* MG; const float* bg; bf16* MX;
    __device__ __forceinline__ void operator()(const AccT& acc, const pg8::Unit& u, int wr, int wc, int fr, int fq) const {
        const int row0 = u.pm * 256 + wr * 64 + fr, col = u.pn * 128 + wc * 32 + 8 * fq;
        const f32x4 b0 = *(const f32x4*)(bg + col), b1 = *(const f32x4*)(bg + col + 4);
#pragma unroll
        for (int ai = 0; ai < 2; ++ai)
#pragma unroll
            for (int m = 0; m < 4; ++m) { const int row = row0 + ai * 128 + m * 16;
                const v4u g = *(const v4u*)(MG + (size_t)row * 2048 + 1024 + col); const v4u t = *(const v4u*)(T + (size_t)row * 1024 + col);
                const f32x4 a0 = acc[ai][0][m][0], a1 = acc[ai][0][m][1], g0 = acc[ai][1][m][0] + b0, g1 = acc[ai][1][m][1] + b1;
                float o[8];
                o[0] = bflo(t.x) + bflo(g.x) * a0.x * sigmoidf_(g0.x); o[1] = bfhi(t.x) + bfhi(g.x) * a0.y * sigmoidf_(g0.y);
                o[2] = bflo(t.y) + bflo(g.y) * a0.z * sigmoidf_(g0.z); o[3] = bfhi(t.y) + bfhi(g.y) * a0.w * sigmoidf_(g0.w);
                o[4] = bflo(t.z) + bflo(g.z) * a1.x * sigmoidf_(g1.x); o[5] = bfhi(t.z) + bfhi(g.z) * a1.y * sigmoidf_(g1.y);
                o[6] = bflo(t.w) + bflo(g.w) * a1.z * sigmoidf_(g1.z); o[7] = bfhi(t.w) + bfhi(g.w) * a1.w * sigmoidf_(g1.w);
                v4u w; w.x = pk2(o[0], o[1]); w.y = pk2(o[2], o[3]); w.z = pk2(o[4], o[5]); w.w = pk2(o[6], o[7]);
                *(v4u*)(MX + (size_t)row * 1024 + col) = w; }
    }
};
struct EpiOut {
    static constexpr bool PERM = false, AFTER_DRAIN = false;
    const float* X; float* V;
    __device__ __forceinline__ void operator()(const AccT& acc, const pg8::Unit& u, int wr, int wc, int fr, int fq) const {
        const int row0 = u.pm * 256 + wr * 64 + fr;
#pragma unroll
        for (int bj = 0; bj < 2; ++bj)
#pragma unroll
            for (int n = 0; n < 2; ++n) { const int col = u.pn * 256 + bj * 128 + wc * 32 + 16 * n + 4 * fq;
#pragma unroll
                for (int ai = 0; ai < 2; ++ai)
#pragma unroll
                    for (int m = 0; m < 4; ++m) { const size_t o = (size_t)(row0 + ai * 128 + m * 16) * 1024 + col;
                        const f32x4 x = *(const f32x4*)(X + o); *(f32x4*)(V + o) = x * DN_ALPHA + acc[ai][bj][m][n]; } }
    }
};
struct EpiMoe1 {
    static constexpr bool PERM = true, AFTER_DRAIN = false;
    bf16* HB;
    __device__ __forceinline__ void operator()(const AccT& acc, const pg8::Unit& u, int wr, int wc, int fr, int fq) const {
        const int row0 = u.pm * 256 + wr * 64 + fr, col = (u.pn & 1) * 128 + wc * 32 + 8 * fq;
#pragma unroll
        for (int ai = 0; ai < 2; ++ai)
#pragma unroll
            for (int m = 0; m < 4; ++m) { const f32x4 g0 = acc[ai][0][m][0], g1 = acc[ai][0][m][1], u0 = acc[ai][1][m][0], u1 = acc[ai][1][m][1];
                v4u w; w.x = pk2(g0.x * sigmoidf_(g0.x) * u0.x, g0.y * sigmoidf_(g0.y) * u0.y); w.y = pk2(g0.z * sigmoidf_(g0.z) * u0.z, g0.w * sigmoidf_(g0.w) * u0.w);
                w.z = pk2(g1.x * sigmoidf_(g1.x) * u1.x, g1.y * sigmoidf_(g1.y) * u1.y); w.w = pk2(g1.z * sigmoidf_(g1.z) * u1.z, g1.w * sigmoidf_(g1.w) * u1.w);
                *(v4u*)(HB + (size_t)(row0 + ai * 128 + m * 16) * 256 + col) = w; }
    }
};
struct EpiMoe2 {
    static constexpr bool PERM = true, AFTER_DRAIN = false;
    bf16* Y;
    __device__ __forceinline__ void operator()(const AccT& acc, const pg8::Unit& u, int wr, int wc, int fr, int fq) const {
        const int row0 = u.pm * 256 + wr * 64 + fr;
#pragma unroll
        for (int bj = 0; bj < 2; ++bj) { const int col = (u.pn & 3) * 256 + bj * 128 + wc * 32 + 8 * fq;
#pragma unroll
            for (int ai = 0; ai < 2; ++ai)
#pragma unroll
                for (int m = 0; m < 4; ++m) { const f32x4 v0 = acc[ai][bj][m][0], v1 = acc[ai][bj][m][1];
                    v4u w; w.x = pk2(v0.x, v0.y); w.y = pk2(v0.z, v0.w); w.z = pk2(v1.x, v1.y); w.w = pk2(v1.z, v1.w);
                    *(v4u*)(Y + (size_t)(row0 + ai * 128 + m * 16) * 1024 + col) = w; } }
    }
};
struct EpiRouter {
    static constexpr bool PERM = false, AFTER_DRAIN = true;
    const float* bg; const float* be; int* route; int* hist;
    __device__ __forceinline__ void fused(const AccT& acc, const pg8::Unit& u, int wr, int wc, int fr, int fq, PG8_LAS unsigned char* lds, int wid, int lane) const {
        PG8_LAS float* LG = (PG8_LAS float*)lds;
        PG8_LAS int* lh = (PG8_LAS int*)(lds + 256 * 76 * 4);
        const int tid = wid * 64 + lane;
        if (tid < 64) lh[tid] = 0;
        if (wc < 3) {
#pragma unroll
            for (int n = 0; n < 2; ++n) { const int c = wc * 32 + 16 * n + 4 * fq;
                if (c < 72) {
#pragma unroll
                    for (int ai = 0; ai < 2; ++ai)
#pragma unroll
                        for (int m = 0; m < 4; ++m) { const pg8::f32x4 v = acc[ai][0][m][n] + acc[ai][1][m][n]; *(PG8_LAS pg8::f32x4*)(LG + (ai * 128 + wr * 64 + m * 16 + fr) * 76 + c) = v; } } }
        }
        asm volatile("s_waitcnt lgkmcnt(0)" ::: "memory"); __builtin_amdgcn_s_barrier(); asm volatile("" ::: "memory");
        const int wg = u.pm - 128;
        if (tid < 256) {
            const PG8_LAS float* l = LG + tid * 76; const int row = wg * 256 + tid;
            float gm = -3.0e38f; int gi = 0; float gl[8];
#pragma unroll
            for (int j = 0; j < 8; ++j) { gl[j] = l[j] + bg[j]; if (gl[j] > gm) { gm = gl[j]; gi = j; } }
            float ge = 0.f;
#pragma unroll
            for (int j = 0; j < 8; ++j) ge += __expf(gl[j] - gm);
            const float pgroup = 1.0f / ge;
            float m1 = -3.0e38f, m2 = -3.0e38f; int i1 = 0, i2 = 0;
#pragma unroll
            for (int j = 0; j < 8; ++j) { const float v = l[8 + gi * 8 + j] + be[gi * 8 + j];
                if (v > m1) { m2 = m1; i2 = i1; m1 = v; i1 = j; } else if (v > m2) { m2 = v; i2 = j; } }
            const float e2 = __expf(m2 - m1), w1 = pgroup / (1.0f + e2), w2 = pgroup * e2 / (1.0f + e2);
            int* rt = route + (size_t)row * 8; const int ex1 = gi * 8 + i1, ex2 = gi * 8 + i2;
            const int r1 = __hip_atomic_fetch_add(lh + ex1, 1, __ATOMIC_RELAXED, __HIP_MEMORY_SCOPE_WORKGROUP), r2 = __hip_atomic_fetch_add(lh + ex2, 1, __ATOMIC_RELAXED, __HIP_MEMORY_SCOPE_WORKGROUP);
            rt[0] = ex1; rt[1] = ex2; rt[2] = __float_as_int(w1); rt[3] = __float_as_int(w2); rt[4] = r1; rt[5] = r2;
        }
        asm volatile("s_waitcnt lgkmcnt(0)" ::: "memory"); __builtin_amdgcn_s_barrier(); asm volatile("" ::: "memory");
        if (tid < 64) hist[wg * 64 + tid] = lh[tid];
    }
};
struct RouterOrder {
    int c;
    __device__ __forceinline__ bool next(int i, pg8::Unit& u) const { if (c >= 128 || i >= 2) return false; u.pm = c + 128 * i; u.pn = i; return true; }
    __device__ __forceinline__ void a_ready(const pg8::Unit&) const {}
    __device__ __forceinline__ void done(const pg8::Unit&) const {}
};
struct ListOrder {
    int n, G, c, per, div;
    __device__ __forceinline__ bool next(int i, pg8::Unit& u) const { const int L = i * G + c; if (L >= n) return false; u.pm = L / per; u.pn = (u.pm / div) * per + L % per; return true; }
    __device__ __forceinline__ void a_ready(const pg8::Unit&) const {}
    __device__ __forceinline__ void done(const pg8::Unit&) const {}
};
struct MoeOrder {
    int n, G, c, per; const LAS unsigned char* tile_e;
    __device__ __forceinline__ bool next(int i, pg8::Unit& u) const { const int L = i * G + c; if (L >= n) return false; u.pm = L / per; u.pn = (int)tile_e[u.pm] * per + L % per; return true; }
    __device__ __forceinline__ void a_ready(const pg8::Unit&) const {}
    __device__ __forceinline__ void done(const pg8::Unit&) const {}
};

__device__ __forceinline__ void p3_thin(Frame& F, const Args& A) {
    unsigned char* ws = F.ws;
    {
        const float* HID = (const float*)(ws + WS_HID); bf16* KC = (bf16*)(ws + WS_KC);
        const int total = 2 * 4096 * 64;
        for (int o = F.vcu * 512 + F.tid; o < total; o += F.G * 512) {
            const int d = o & 63, row = o >> 6, j = row >> 12;
            const float* h = HID + (size_t)row * 128; const float* w = A.in[I_CW2] + (size_t)j * 128 * 64 + d;
            float s = A.in[I_CB2][j * 64 + d];
#pragma unroll 8
            for (int m = 0; m < 128; ++m) s += h[m] * w[m * 64];
            KC[o] = (bf16)(pk2(s, 0.f) & 0xffffu);
        }
    }
    if (F.wave == 0) {
        for (int gb = F.vcu; gb < 256; gb += F.G) {
            const int p = F.lane; const float* a16 = (const float*)(ws + WS_SMALL + SM_A16) + (size_t)((gb >> 3) * 64 + p) * 2; const float ar = a16[0], ai = a16[1];
            const float* E = (const float*)(ws + WS_E) + (size_t)gb * 256 * 128; bf16* SA = (bf16*)(ws + WS_SA) + (size_t)gb * 256 * 384;
            float xr = 0.f, xi = 0.f;
            for (int c0 = 0; c0 < 256; c0 += 8) {
                float er[8], ei[8];
#pragma unroll
                for (int k = 0; k < 8; ++k) { er[k] = E[(size_t)(c0 + k) * 128 + p]; ei[k] = E[(size_t)(c0 + k) * 128 + 64 + p]; }
#pragma unroll
                for (int k = 0; k < 8; ++k) { bf16* row = SA + (size_t)(c0 + k) * 384; row[p] = (bf16)(pk2(xr, 0.f) & 0xffffu); row[64 + p] = (bf16)(pk2(xi, 0.f) & 0xffffu);
                    const float nr = ar * xr - ai * xi + er[k], ni = ar * xi + ai * xr + ei[k]; xr = nr; xi = ni; }
            }
        }
    }
}


namespace att2 {
#ifndef PROBE_SECTION
#define PROBE_SECTION 0
#endif
#define TSEC_BEGIN(id) unsigned long long t_sec_ = 0; if (PROBE_SECTION == (id)) t_sec_ = __builtin_amdgcn_s_memtime()
#define TSEC_END(id, P) do { if (PROBE_SECTION == (id)) (P).tacc += __builtin_amdgcn_s_memtime() - t_sec_; } while (0)
typedef short bf16x8 __attribute__((ext_vector_type(8)));
typedef short s16x4 __attribute__((ext_vector_type(4)));
typedef float f32x16 __attribute__((ext_vector_type(16)));
typedef short v4i16_t __attribute__((ext_vector_type(4)));
typedef LAS const char* lds_cptr;
#define A2_MFMA(a, b, c) __builtin_amdgcn_mfma_f32_32x32x16_bf16(a, b, c, 0, 0, 0)
constexpr int SLOTB = 8192, NSLOT = 4, L_K = 0, L_V = NSLOT * SLOTB, L_LUT = 2 * NSLOT * SLOTB, L_WS = L_LUT + 4096, WS_PER_WAVE = 7168;
constexpr int W_WSF = 0, W_TBL = 128, W_GATE = 256, W_IMP = 768, W_OST = 3072;
static_assert(L_WS + 8 * WS_PER_WAVE <= 131072, "attention LDS map");
constexpr float MASKED = -2.0e30f, MINIT = -1.0e30f, THR = 8.0f;
__device__ __forceinline__ int crow(int r, int hi) { return (r & 3) + 8 * (r >> 2) + 4 * hi; }
__device__ __forceinline__ s16x4 vtr(lds_cptr p) { return __builtin_bit_cast(s16x4, __builtin_amdgcn_ds_read_tr16_b64_v4i16((LAS v4i16_t*)p)); }
#define A2_MX3(a, b, c) __builtin_fmaxf(__builtin_fmaxf((a), (b)), (c))
__device__ __forceinline__ float rowmax(const f32x16& p0, const f32x16& p1) {
    float a = A2_MX3(p0[0], p0[1], p1[0]), b = A2_MX3(p0[2], p0[3], p1[1]); a = A2_MX3(a, p1[2], p1[3]);
#pragma unroll
    for (int r = 4; r < 16; r += 4) { a = A2_MX3(a, p0[r], p0[r + 1]); b = A2_MX3(b, p0[r + 2], p0[r + 3]); a = A2_MX3(a, p1[r], p1[r + 1]); b = A2_MX3(b, p1[r + 2], p1[r + 3]); }
    const float m = __builtin_fmaxf(a, b); auto rr = __builtin_amdgcn_permlane32_swap(__float_as_uint(m), __float_as_uint(m), false, false);
    return __builtin_fmaxf(__uint_as_float(rr[0]), __uint_as_float(rr[1])); }
__device__ __forceinline__ float halfsum(float v) { auto rr = __builtin_amdgcn_permlane32_swap(__float_as_uint(v), __float_as_uint(v), false, false); return __uint_as_float(rr[0]) + __uint_as_float(rr[1]); }

struct Ctx {
    LAS unsigned char* lds;
    int wid, lane, r32, hi;
    int tq;
    int hg;
    bf16x8 qr[4];
};
__device__ __forceinline__ void glds16(const void* g, unsigned lds_base) {
    unsigned sv; asm volatile("s_mov_b32 %0, m0\n\ts_mov_b32 m0, %2\n\ts_nop 0\n\tglobal_load_lds_dwordx4 %1, off\n\ts_mov_b32 m0, %0" : "=&s"(sv) : "v"(g), "s"(lds_base) : "memory"); }
__device__ __forceinline__ void stage(const Ctx& C, const bf16* ksrc, const bf16* vsrc, int slot) {
    const unsigned base = (unsigned)(uintptr_t)C.lds + (unsigned)(slot * SLOTB + C.wid * 1024);
    glds16(ksrc + (size_t)C.lane * 64 + C.wid * 8, (unsigned)__builtin_amdgcn_readfirstlane((int)(base + L_K)));
    glds16(vsrc + (size_t)(16 * (C.wid & 3) + (C.lane >> 2)) * 64 + (C.wid >> 2) * 32 + (C.lane & 3) * 8, (unsigned)__builtin_amdgcn_readfirstlane((int)(base + L_V)));
}
struct Pipe {
    const bf16 *KV, *KC; int w;
    int k, pass, idx, n; const bf16 *kb, *vb;
    int issued, s;
    unsigned long long tacc;
    __device__ __forceinline__ int qt_of(int kk) const { const int r = w & 15; return kk == 0 ? r : (kk == 1 ? 31 - r : (kk == 2 ? 32 + r : 63 - r)); }
    __device__ __forceinline__ void setup_pass() {
        const int bg = w >> 4, qt = qt_of(k); const size_t kvslab = (size_t)bg * 4096 * 64, kvstride = (size_t)NB * 2 * 4096 * 64;
        if (pass < 2) { n = (4 * qt + 66) >> 6; kb = KC + (size_t)bg * 256 * 64; vb = kb + (size_t)16 * 256 * 64; }
        else if (pass == 2) { n = qt + 1; kb = KV + 2 * kvstride + kvslab; vb = kb + kvstride; }
        else { const int j0 = qt > 8 ? qt - 8 : 0; n = qt - j0 + 1; kb = KV + 4 * kvstride + kvslab + (size_t)j0 * 4096; vb = kb + kvstride; }
    }
    __device__ __forceinline__ void init(const bf16* KV_, const bf16* KC_, int w_) { KV = KV_; KC = KC_; w = w_; k = 0; pass = 0; idx = 0; issued = 0; s = 0; tacc = 0; setup_pass(); }
    __device__ __forceinline__ void issue_next(const Ctx& C) {
        if (k < 4) { stage(C, kb + (size_t)idx * 4096, vb + (size_t)idx * 4096, issued & (NSLOT - 1)); ++issued; ++idx;
            if (idx == n) { idx = 0; ++pass; if (pass == 4) { pass = 0; ++k; } if (k < 4) setup_pass(); } }
    }
    __device__ __forceinline__ void wait_bar(int pending) {
        if (pending >= 2) asm volatile("s_waitcnt vmcnt(4) lgkmcnt(0)" ::: "memory"); else if (pending == 1) asm volatile("s_waitcnt vmcnt(2) lgkmcnt(0)" ::: "memory"); else asm volatile("s_waitcnt vmcnt(0) lgkmcnt(0)" ::: "memory");
        __builtin_amdgcn_s_barrier(); asm volatile("" ::: "memory");
    }
    __device__ __forceinline__ void prologue(const Ctx& C) { issue_next(C); issue_next(C); issue_next(C); wait_bar(issued - 1); }
    __device__ __forceinline__ int slot() const { return s & (NSLOT - 1); }
    __device__ __forceinline__ void begin_step(const Ctx& C) { issue_next(C); }
    __device__ __forceinline__ void end_step() { TSEC_BEGIN(1); wait_bar(issued - (s + 2)); TSEC_END(1, *this); ++s; }
};
__device__ __forceinline__ void scores(const Ctx& C, int slot, f32x16& s0, f32x16& s1) {
    const lds_cptr kp = (lds_cptr)C.lds + L_K + slot * SLOTB + C.hi * 1024 + C.r32 * 16;
    bf16x8 kf[8];
#pragma unroll
    for (int d0 = 0; d0 < 4; ++d0) { kf[2 * d0] = *(const LAS bf16x8*)(kp + d0 * 2048); kf[2 * d0 + 1] = *(const LAS bf16x8*)(kp + d0 * 2048 + 512); }
    f32x16 z;
#pragma unroll
    for (int i = 0; i < 16; ++i) z[i] = 0.f;
    s0 = A2_MFMA(kf[0], C.qr[0], z); s1 = A2_MFMA(kf[1], C.qr[0], z);
    s0 = A2_MFMA(kf[2], C.qr[1], s0); s1 = A2_MFMA(kf[3], C.qr[1], s1);
    s0 = A2_MFMA(kf[4], C.qr[2], s0); s1 = A2_MFMA(kf[5], C.qr[2], s1);
    s0 = A2_MFMA(kf[6], C.qr[3], s0); s1 = A2_MFMA(kf[7], C.qr[3], s1);
}
__device__ __forceinline__ void bias_far(f32x16& s0, f32x16& s1, float cl) {
#pragma unroll
    for (int r = 0; r < 16; ++r) { s0[r] += cl; s1[r] += cl; }
}
__device__ __forceinline__ void bias_near(const Ctx& C, f32x16& s0, f32x16& s1, int kbase, int kstep, int maxd, bool colsel) {
    const unsigned lutb = (unsigned)(uintptr_t)(C.lds + L_LUT) + (unsigned)C.hg * 4u;
    const int d0 = C.tq - kbase - kstep * 4 * C.hi;
#pragma unroll
    for (int half = 0; half < 2; ++half) {
        f32x16& sx = half ? s1 : s0; const int dh = d0 - half * 32 * kstep;
#pragma unroll
        for (int q4 = 0; q4 < 2; ++q4) {
            unsigned ad[8]; float bb[8];
#pragma unroll
            for (int i = 0; i < 8; ++i) { const int r = q4 * 8 + i; const int da = dh - kstep * ((r & 3) + 8 * (r >> 2)); const int ia = da < 0 ? 0 : (da > 127 ? 127 : da); ad[i] = lutb + (unsigned)ia * 32u; }
            asm volatile("ds_read_b32 %0, %8\n\tds_read_b32 %1, %9\n\tds_read_b32 %2, %10\n\tds_read_b32 %3, %11\n\tds_read_b32 %4, %12\n\tds_read_b32 %5, %13\n\tds_read_b32 %6, %14\n\tds_read_b32 %7, %15\n\ts_waitcnt lgkmcnt(0)"
                         : "=&v"(bb[0]), "=&v"(bb[1]), "=&v"(bb[2]), "=&v"(bb[3]), "=&v"(bb[4]), "=&v"(bb[5]), "=&v"(bb[6]), "=&v"(bb[7])
                         : "v"(ad[0]), "v"(ad[1]), "v"(ad[2]), "v"(ad[3]), "v"(ad[4]), "v"(ad[5]), "v"(ad[6]), "v"(ad[7]) : "memory");
#pragma unroll
            for (int i = 0; i < 8; ++i) { const int r = q4 * 8 + i; const int da = dh - kstep * ((r & 3) + 8 * (r >> 2)); const bool ok = colsel && da >= 0 && da <= maxd; const float v = sx[r] + bb[i]; sx[r] = ok ? v : MASKED; }
        }
    }
}
struct Acc { f32x16 o[2]; float m, l; };
__device__ __forceinline__ void acc_zero(Acc& a) {
#pragma unroll
    for (int i = 0; i < 16; ++i) { a.o[0][i] = 0.f; a.o[1][i] = 0.f; }
    a.m = MINIT; a.l = 0.f;
}
__device__ __forceinline__ void pv(const Ctx& C, int slot, const f32x16& p0, const f32x16& p1, f32x16 (&o)[2]) {
    v4u pw[4];
#pragma unroll
    for (int k = 0; k < 2; ++k) { pw[k] = (v4u){pk2(p0[8 * k], p0[8 * k + 1]), pk2(p0[8 * k + 2], p0[8 * k + 3]), pk2(p0[8 * k + 4], p0[8 * k + 5]), pk2(p0[8 * k + 6], p0[8 * k + 7])};
                                  pw[2 + k] = (v4u){pk2(p1[8 * k], p1[8 * k + 1]), pk2(p1[8 * k + 2], p1[8 * k + 3]), pk2(p1[8 * k + 4], p1[8 * k + 5]), pk2(p1[8 * k + 6], p1[8 * k + 7])}; }
    const lds_cptr vp = (lds_cptr)C.lds + L_V + slot * SLOTB + ((C.lane >> 4) & 1) * 32 + (C.lane & 3) * 8 + (4 * C.hi + ((C.lane & 15) >> 2)) * 64;
#pragma unroll
    for (int dh = 0; dh < 2; ++dh) {
        s16x4 vlo[4], vhi[4];
#pragma unroll
        for (int k = 0; k < 4; ++k) { vlo[k] = vtr(vp + dh * 4096 + k * 1024); vhi[k] = vtr(vp + dh * 4096 + k * 1024 + 512); }
#pragma unroll
        for (int k = 0; k < 4; ++k) { const bf16x8 vf = (bf16x8){vlo[k][0], vlo[k][1], vlo[k][2], vlo[k][3], vhi[k][0], vhi[k][1], vhi[k][2], vhi[k][3]};
            o[dh] = A2_MFMA(__builtin_bit_cast(bf16x8, pw[k]), vf, o[dh]); }
    }
}
__device__ __forceinline__ void softmax_step(const Ctx& C, Acc& a, f32x16& s0, f32x16& s1, float cl) {
    LAS float* wsf = (LAS float*)(C.lds + L_WS + C.wid * WS_PER_WAVE + W_WSF);
    const float mt = rowmax(s0, s1) + cl;
    if (__any(mt - a.m > THR)) {
        const float mn = __builtin_fmaxf(a.m, mt), f = __builtin_amdgcn_exp2f(a.m - mn);
        a.l *= f; a.m = mn;
        if (C.hi == 0) wsf[C.r32] = f;
        asm volatile("s_waitcnt lgkmcnt(0)" ::: "memory");
#pragma unroll
        for (int r = 0; r < 16; ++r) { const float fr = wsf[crow(r, C.hi)]; a.o[0][r] *= fr; a.o[1][r] *= fr; }
        asm volatile("s_waitcnt lgkmcnt(0)" ::: "memory");
    }
    const float nm = cl - a.m; float sacc = 0.f;
#pragma unroll
    for (int r = 0; r < 16; ++r) { s0[r] = __builtin_amdgcn_exp2f(s0[r] + nm); s1[r] = __builtin_amdgcn_exp2f(s1[r] + nm); sacc += s0[r] + s1[r]; }
    a.l += sacc;
}
__device__ __forceinline__ void fold(const Ctx& C, const Acc& a, int branch, f32x16 (&out)[2]) {
    LAS float* tbl = (LAS float*)(C.lds + L_WS + C.wid * WS_PER_WAVE + W_TBL);
    const LAS float* gate = (const LAS float*)(C.lds + L_WS + C.wid * WS_PER_WAVE + W_GATE);
    const float l = halfsum(a.l);
    if (C.hi == 0) tbl[C.r32] = (l > 0.f ? __builtin_amdgcn_rcpf(l) : 0.f) * gate[C.r32 * 4 + branch];
    asm volatile("s_waitcnt lgkmcnt(0)" ::: "memory");
#pragma unroll
    for (int r = 0; r < 16; ++r) { const float f = tbl[crow(r, C.hi)]; out[0][r] += f * a.o[0][r]; out[1][r] += f * a.o[1][r]; }
    asm volatile("s_waitcnt lgkmcnt(0)" ::: "memory");
}

__device__ __forceinline__ void unit(Ctx& C, Pipe& P, int b, int g, int qt, const bf16* Q, const bf16* GT, bf16* O) {
    LAS unsigned char* lds = C.lds; const int wid = C.wid, lane = C.lane;
    const int t0 = qt * 64, ql = C.r32 >> 2, hl = C.r32 & 3;
    C.tq = t0 + 8 * wid + ql; C.hg = g * 4 + hl;
    const size_t row = (size_t)b * 4096 + C.tq;
    LAS unsigned char* wsb = lds + L_WS + wid * WS_PER_WAVE;
#pragma unroll
    for (int d0 = 0; d0 < 4; ++d0) C.qr[d0] = *(const bf16x8*)(Q + row * 512 + C.hg * 64 + d0 * 16 + C.hi * 8);
    if (C.hi == 0) { LAS float* gate = (LAS float*)(wsb + W_GATE);
#pragma unroll
        for (int br = 0; br < 3; ++br) gate[C.r32 * 4 + br] = bf2f(GT[row * 32 + C.hg * 3 + br]); }
    { LAS float* imp = (LAS float*)(wsb + W_IMP);
#pragma unroll
        for (int i = 0; i < 8; ++i) imp[lane + 64 * i] = 0.f; }
    const float lut31 = ((const LAS float*)(lds + L_LUT))[127 * 8 + C.hg];
    f32x16 out[2];
#pragma unroll
    for (int i = 0; i < 16; ++i) { out[0][i] = 0.f; out[1][i] = 0.f; }
    Acc a; f32x16 s0, s1;
    const int tmax = t0 + 63, nvis_max = tmax >= 31 ? ((tmax - 31) >> 4) + 1 : 0, ntc = (nvis_max + 63) >> 6;
    const int twmin = t0 + 8 * wid;
    float mc = MINIT, lc = 0.f;
#pragma unroll 1
    for (int tl = 0; tl < ntc; ++tl) {
        P.begin_step(C);
        scores(C, P.slot(), s0, s1);
        float cl = 0.f;
        if (twmin - (16 * (64 * tl + 63) + 31) >= 113) cl = lut31; else bias_near(C, s0, s1, 16 * 64 * tl + 31, 16, 1 << 30, true);
        const float mt = rowmax(s0, s1) + cl, mn = __builtin_fmaxf(mc, mt); float sacc = 0.f; const float nm = cl - mn;
#pragma unroll
        for (int r = 0; r < 16; ++r) sacc += __builtin_amdgcn_exp2f(s0[r] + nm) + __builtin_amdgcn_exp2f(s1[r] + nm);
        lc = lc * __builtin_amdgcn_exp2f(mc - mn) + sacc; mc = mn;
        P.end_step();
    }
    { const float lf = halfsum(lc); lc = lf > 0.f ? __builtin_amdgcn_rcpf(lf) : 0.f; }
    acc_zero(a);
#pragma unroll 1
    for (int tl = 0; tl < ntc; ++tl) {
        P.begin_step(C);
        scores(C, P.slot(), s0, s1);
        float cl = 0.f;
        if (twmin - (16 * (64 * tl + 63) + 31) >= 113) cl = lut31; else bias_near(C, s0, s1, 16 * 64 * tl + 31, 16, 1 << 30, true);
        const float nm = cl - mc;
#pragma unroll
        for (int r = 0; r < 16; ++r) { s0[r] = __builtin_amdgcn_exp2f(s0[r] + nm) * lc; s1[r] = __builtin_amdgcn_exp2f(s1[r] + nm) * lc; }
        {
            LAS float* imp = (LAS float*)(wsb + W_IMP) + ql * 64;
#pragma unroll
            for (int aa = 0; aa < 4; ++aa) {
                const int nb0 = 16 * tl + 2 * aa + C.hi, nb1 = nb0 + 8;
                const float g0 = (s0[4 * aa] + s0[4 * aa + 1]) + (s0[4 * aa + 2] + s0[4 * aa + 3]), g1 = (s1[4 * aa] + s1[4 * aa + 1]) + (s1[4 * aa + 2] + s1[4 * aa + 3]);
                (void)__hip_atomic_fetch_add(imp + nb0, g0, __ATOMIC_RELAXED, __HIP_MEMORY_SCOPE_WORKGROUP);
                (void)__hip_atomic_fetch_add(imp + nb1, g1, __ATOMIC_RELAXED, __HIP_MEMORY_SCOPE_WORKGROUP);
                if (nb0 + 1 < 64) (void)__hip_atomic_fetch_add(imp + nb0 + 1, s0[4 * aa + 3], __ATOMIC_RELAXED, __HIP_MEMORY_SCOPE_WORKGROUP);
                if (nb1 + 1 < 64) (void)__hip_atomic_fetch_add(imp + nb1 + 1, s1[4 * aa + 3], __ATOMIC_RELAXED, __HIP_MEMORY_SCOPE_WORKGROUP);
            }
        }
        pv(C, P.slot(), s0, s1, a.o);
        P.end_step();
    }
    a.l = 0.5f;
    fold(C, a, 0, out);
    unsigned long long mymask = 0ull, anymask = 0ull;
    { TSEC_BEGIN(6);
        const LAS float* imp = (const LAS float*)(wsb + W_IMP);
        const int n = lane; const bool forced = (n == 0) || (n == qt) || (n == qt - 1), val = n <= qt;
#pragma unroll 1
        for (int q8 = 0; q8 < 8; ++q8) {
            const float score = forced ? 1e9f : (val ? imp[q8 * 64 + n] : -1e9f);
            const unsigned u = __float_as_uint(score), key = (u & 0x80000000u) ? ~u : (u | 0x80000000u);
            unsigned T = 0u;
#pragma unroll
            for (int bit = 31; bit >= 0; --bit) { const unsigned cand = T | (1u << bit); if (__builtin_popcountll(__ballot(key >= cand)) >= 16) T = cand; }
            unsigned long long gt = __ballot(key > T), eq = __ballot(key == T);
            int need = 16 - __builtin_popcountll(gt);
            while (need > 0 && eq) { const unsigned long long low = eq & (0ull - eq); gt |= low; eq ^= low; --need; }
            const unsigned long long sel = gt & __ballot(val);
            anymask |= sel; if (ql == q8) mymask = sel;
        }
      TSEC_END(6, P); }
#pragma unroll 1
    for (int ph = 0; ph < 2; ++ph) {
        acc_zero(a);
        const int j0 = ph ? (qt > 8 ? qt - 8 : 0) : 0, nj = qt - j0 + 1, maxd = ph ? 511 : (1 << 30);
#pragma unroll 1
        for (int i = 0; i < nj; ++i) {
            const int j = j0 + i;
            P.begin_step(C);
            const bool wave_on = ph ? true : ((anymask >> j) & 1ull) != 0ull;
            if (wave_on) {
                const bool colsel = ph ? true : ((mymask >> j) & 1ull) != 0ull;
                { TSEC_BEGIN(2); scores(C, P.slot(), s0, s1); asm volatile("" : "+v"(s0), "+v"(s1)); TSEC_END(2, P); }
                const bool far = (j <= qt - 3) && !(ph && j == qt - 8);
                float cl = 0.f;
                { TSEC_BEGIN(3); if (far) cl = colsel ? lut31 : MASKED; else bias_near(C, s0, s1, 64 * j, 1, maxd, colsel); asm volatile("" : "+v"(s0), "+v"(s1)); TSEC_END(3, P); }
                { TSEC_BEGIN(4); softmax_step(C, a, s0, s1, cl); asm volatile("" : "+v"(s0), "+v"(s1)); TSEC_END(4, P); }
                { TSEC_BEGIN(5); pv(C, P.slot(), s0, s1, a.o); asm volatile("" : "+v"(a.o[0]), "+v"(a.o[1])); TSEC_END(5, P); }
            }
            P.end_step();
        }
        fold(C, a, 1 + ph, out);
    }
    {
        bf16* stg = (bf16*)(wsb + W_OST);
#pragma unroll
        for (int r = 0; r < 16; ++r) { const int c = crow(r, C.hi);
            stg[c * 64 + C.r32] = (bf16)(pk2(out[0][r], 0.f) & 0xffffu); stg[c * 64 + 32 + C.r32] = (bf16)(pk2(out[1][r], 0.f) & 0xffffu); }
        asm volatile("s_waitcnt lgkmcnt(0)" ::: "memory");
#pragma unroll
        for (int i = 0; i < 4; ++i) { const int c = i * 8 + (lane >> 3), ch = lane & 7;
            const v4u v = *(const LAS v4u*)(stg + c * 64 + ch * 8);
            *(v4u*)(O + ((size_t)b * 4096 + t0 + 8 * wid + (c >> 2)) * 512 + (g * 4 + (c & 3)) * 64 + ch * 8) = v; }
        asm volatile("s_waitcnt lgkmcnt(0)" ::: "memory");
    }
}
}

__device__ __forceinline__ void p4_attention(Frame& F, const Args& A) {
    unsigned char* ws = F.ws;
    LAS unsigned char* lds = F.lds + RING_OFF;
    { LAS float* lut = (LAS float*)(lds + att2::L_LUT); for (int e = F.tid; e < 1024; e += 512) lut[e] = ((const float*)(ws + WS_SMALL + SM_LUT))[e] * 1.4426950408889634f; }
    __syncthreads();
    const bf16* Q = (const bf16*)(ws + WS_Q); const bf16* KV = (const bf16*)(ws + WS_KV); const bf16* KC = (const bf16*)(ws + WS_KC); const bf16* GT = (const bf16*)(ws + WS_G);
    bf16* O = (bf16*)(ws + WS_O);
#ifndef PROBE_ATTN_REPS
#define PROBE_ATTN_REPS 1
#endif
    for (int ww = F.vcu; ww < 256 * PROBE_ATTN_REPS; ww += F.G) {
        const int w = ww & 255; const int bg = w >> 4, b = bg >> 1, g = bg & 1;
        att2::Ctx C; C.lds = lds; C.wid = F.wave; C.lane = F.lane; C.r32 = F.lane & 31; C.hi = F.lane >> 5;
        att2::Pipe P; P.init(KV, KC, w); P.prologue(C);
#pragma unroll 1
        for (int k = 0; k < 4; ++k) att2::unit(C, P, b, g, P.qt_of(k), Q, GT, O);
        asm volatile("s_waitcnt vmcnt(0) lgkmcnt(0)" ::: "memory"); __builtin_amdgcn_s_barrier(); asm volatile("" ::: "memory");
        if (PROBE_SECTION != 0 && F.wave == 0) { const unsigned long long t0 = __builtin_amdgcn_s_memtime(); while (__builtin_amdgcn_s_memtime() - t0 < P.tacc) __builtin_amdgcn_s_sleep(4); }
        if (PROBE_SECTION != 0) __builtin_amdgcn_s_barrier();
    }
}

__device__ __forceinline__ void p8_ln(Frame& F, const Args& A) {
    unsigned char* ws = F.ws; const int lane = F.lane;
    float* H1 = (float*)(ws + WS_H1); bf16* H1B = (bf16*)(ws + WS_H1B); bf16* HLO = (bf16*)(ws + WS_HLO);
    const int gw = F.vcu * NWAVES + F.wave, NGW = F.G * NWAVES;
    f32x4 gam[4], bet[4];
#pragma unroll
    for (int j = 0; j < 4; ++j) { gam[j] = ((const f32x4*)A.in[I_LN1G])[lane + 64 * j]; bet[j] = ((const f32x4*)A.in[I_LN1B])[lane + 64 * j]; }
#pragma unroll 2
    for (int m = gw; m < NTOK; m += NGW) {
        f32x4* xr = (f32x4*)(H1 + (size_t)m * DM) + lane; f32x4 h[4]; float s = 0.f;
#pragma unroll
        for (int j = 0; j < 4; ++j) { h[j] = xr[64 * j]; s += (h[j].x + h[j].y) + (h[j].z + h[j].w); }
        const float mean = wave_sum(s) * (1.f / DM); float s2 = 0.f;
#pragma unroll
        for (int j = 0; j < 4; ++j) { h[j] = h[j] - mean; s2 += (h[j].x * h[j].x + h[j].y * h[j].y) + (h[j].z * h[j].z + h[j].w * h[j].w); }
        const float rstd = 1.0f / sqrtf(wave_sum(s2) * (1.f / DM) + LN_EPS);
        v2u* o8 = (v2u*)(H1B + (size_t)m * DM) + lane; v2u* l8 = (v2u*)(HLO + (size_t)m * DM) + lane;
#pragma unroll
        for (int j = 0; j < 4; ++j) { h[j] = h[j] * rstd * gam[j] + bet[j]; xr[64 * j] = h[j];
            v2u w; w.x = pk2(h[j].x, h[j].y); w.y = pk2(h[j].z, h[j].w); o8[64 * j] = w;
            v2u q; q.x = pk2(h[j].x - bflo(w.x), h[j].y - bfhi(w.x)); q.y = pk2(h[j].z - bflo(w.y), h[j].w - bfhi(w.y)); l8[64 * j] = q; }
    }
}
template <class P> __device__ __forceinline__ int moe_tables(Frame& F, P cnt, LAS int* pstart  , LAS unsigned char* tile_e  ) {
    LAS int* nt = (LAS int*)(pstart + 64);
    if (F.tid == 0) { int acc = 0;
        for (int e = 0; e < 64; ++e) { const int c = (int)cnt[e]; const int tiles = (c + 255) >> 8; pstart[e] = acc * 256;
            for (int k = 0; k < tiles; ++k) tile_e[acc + k] = (unsigned char)e; acc += tiles; }
        nt[0] = acc; }
    __syncthreads();
    return nt[0];
}
__device__ __forceinline__ void p9_scatter(Frame& F, const Args& A) {
    unsigned char* ws = F.ws; const int lane = F.lane;
    LAS int* pstart = (LAS int*)(F.lds + LTAB_OFF); LAS unsigned char* tile_e = (LAS unsigned char*)(F.lds + LTAB_OFF + 512);
    LAS int* pre = (LAS int*)(F.lds + RING_OFF);
    LAS int* tot = pre + 128 * 64;
    const int* HIST = (const int*)(ws + WS_HIST);
    if (F.tid < 64) { int acc = 0;
#pragma unroll 8
        for (int w = 0; w < 128; ++w) { pre[w * 64 + F.tid] = acc; acc += HIST[w * 64 + F.tid]; }
        tot[F.tid] = acc; if (F.vcu == 0) ((int*)F.ctl)[CW_CNT + F.tid] = acc; }
    __syncthreads();
    (void)moe_tables(F, tot, pstart, tile_e);
    const bf16* H1B = (const bf16*)(ws + WS_H1B); bf16* XS = (bf16*)(ws + WS_XS); int* ROUTE = (int*)(ws + WS_ROUTE);
    const int gw = F.vcu * NWAVES + F.wave, NGW = F.G * NWAVES;
#pragma unroll 1
    for (int t0 = gw * 16; t0 < NTOK; t0 += NGW * 16) {
        int p1 = 0, p2 = 0;
        if (lane < 16) { int* rt = ROUTE + (size_t)(t0 + lane) * 8; const int e1 = rt[0], e2 = rt[1], w = (t0 + lane) >> 8;
            p1 = pstart[e1] + pre[w * 64 + e1] + rt[4]; p2 = pstart[e2] + pre[w * 64 + e2] + rt[5]; rt[6] = p1; rt[7] = p2; }
#pragma unroll 4
        for (int k = 0; k < 16; ++k) {
            const int q1 = __shfl(p1, k), q2 = __shfl(p2, k);
            const v4u* src = (const v4u*)(H1B + (size_t)(t0 + k) * DM) + lane; const v4u a = src[0], b = src[64];
            v4u* d1 = (v4u*)(XS + (size_t)q1 * DM) + lane; v4u* d2 = (v4u*)(XS + (size_t)q2 * DM) + lane;
            d1[0] = a; d1[64] = b; d2[0] = a; d2[64] = b;
        }
    }
}
__device__ __forceinline__ void p12_final(Frame& F, const Args& A, float* out) {
    unsigned char* ws = F.ws; const int lane = F.lane;
    const float* H1 = (const float*)(ws + WS_H1); const bf16* Y2 = (const bf16*)(ws + WS_Y2); const int* ROUTE = (const int*)(ws + WS_ROUTE);
    const int gw = F.vcu * NWAVES + F.wave, NGW = F.G * NWAVES;
    f32x4 gam[4], bet[4];
#pragma unroll
    for (int j = 0; j < 4; ++j) { gam[j] = ((const f32x4*)A.in[I_LN2G])[lane + 64 * j]; bet[j] = ((const f32x4*)A.in[I_LN2B])[lane + 64 * j]; }
    for (int m = gw; m < NTOK; m += NGW) {
        const int* rt = ROUTE + (size_t)m * 8; const float w1 = __int_as_float(rt[2]), w2 = __int_as_float(rt[3]); const int p1 = rt[6], p2 = rt[7];
        const f32x4* xr = (const f32x4*)(H1 + (size_t)m * DM) + lane; const v2u* y1 = (const v2u*)(Y2 + (size_t)p1 * DM) + lane; const v2u* y2 = (const v2u*)(Y2 + (size_t)p2 * DM) + lane;
        f32x4 v[4]; float s = 0.f;
#pragma unroll
        for (int j = 0; j < 4; ++j) { const f32x4 x = xr[64 * j]; const v2u a = y1[64 * j], b = y2[64 * j];
            v[j].x = x.x * DN_ALPHA + (w1 * bflo(a.x) + w2 * bflo(b.x)); v[j].y = x.y * DN_ALPHA + (w1 * bfhi(a.x) + w2 * bfhi(b.x));
            v[j].z = x.z * DN_ALPHA + (w1 * bflo(a.y) + w2 * bflo(b.y)); v[j].w = x.w * DN_ALPHA + (w1 * bfhi(a.y) + w2 * bfhi(b.y));
            s += (v[j].x + v[j].y) + (v[j].z + v[j].w); }
        const float mean = wave_sum(s) * (1.f / DM); float s2 = 0.f;
#pragma unroll
        for (int j = 0; j < 4; ++j) { v[j] = v[j] - mean; s2 += (v[j].x * v[j].x + v[j].y * v[j].y) + (v[j].z * v[j].z + v[j].w * v[j].w); }
        const float rstd = 1.0f / sqrtf(wave_sum(s2) * (1.f / DM) + LN_EPS);
        f32x4* o = (f32x4*)(out + (size_t)m * DM) + lane;
#pragma unroll
        for (int j = 0; j < 4; ++j) o[64 * j] = v[j] * rstd * gam[j] + bet[j];
    }
}

__global__ void __launch_bounds__(NWAVES * 64, 2) fwd(Args args) {
    extern __shared__ __attribute__((aligned(16))) unsigned char lds[];
    Frame F;
    F.lds = (LAS unsigned char*)lds;
    F.MISC = (volatile LAS unsigned*)(F.lds + MISC_OFF);
    F.tid = threadIdx.x; F.lane = F.tid & 63; F.wave = __builtin_amdgcn_readfirstlane(F.tid >> 6);
    F.G = gridDim.x; { const int bx = blockIdx.x; F.vcu = (F.G % 8 == 0) ? (bx % 8) * (F.G / 8) + bx / 8 : bx; }
    F.ws = args.ws; F.ctl = (gu32*)(args.ws + WS_CTL); F.in = nullptr;
    unsigned char* ws = args.ws;
    for (int u = F.tid; u < (LDS_BYTES - LDSCTL_OFF) / 4; u += NWAVES * 64) ((LAS unsigned*)(F.lds + LDSCTL_OFF))[u] = 0u;
    __syncthreads();
    XcdBarrier bar; bar.bar = (unsigned*)(F.ctl + CW_BAR); bar.x = 0; bar.st = nullptr;
    if (MK_N_LAUNCHES == 1) bar = xcd_barrier_post((unsigned*)(F.ctl + CW_BAR), F.MISC + 8);
#define GRID_BAR() do { if (MK_N_LAUNCHES == 1) xcd_barrier(bar); } while (0)
    const int lo = args.ph_lo, hi = args.ph_hi;
#ifndef PH_MASK
#define PH_MASK 0x1fff
#endif
#define IN(k) ((((PH_MASK) >> (k)) & 1) && lo <= (k) && (k) < hi)
#define BOTH(k) (IN(k) && IN((k) + 1))
#ifndef PROBE_REP_MASK
#define PROBE_REP_MASK 0
#endif
#define REPS(k) for (int rep_ = 0; rep_ < 1 + (((PROBE_REP_MASK) >> (k)) & 1); ++rep_)
    LAS unsigned char* ring = F.lds + RING_OFF;

    if (IN(0)) { _Pragma("unroll") REPS(0) { p0_prologue(F, args); __syncthreads(); } if (BOTH(0)) GRID_BAR(); }
    if (IN(1)) {
        pg8::Gemm g{(const bf16*)(ws + WS_XB), (const bf16*)(ws + WS_WINT), 1024, 1024, 1024}; pg8::StaticOrder S; S.init(NTOK, NPROJ, F.G, (int)blockIdx.x);
        EpiProj E{(bf16*)(ws + WS_Q), (bf16*)(ws + WS_KV), (bf16*)(ws + WS_SA), (bf16*)(ws + WS_MG), (bf16*)(ws + WS_G), (const float*)(ws + WS_SMALL + SM_BIASR)};
        _Pragma("unroll") REPS(1) { pg8::gemm_phase<EpiProj, pg8::StaticOrder, true, true>(ring, g, S, E); }
        if (BOTH(1)) GRID_BAR();
    }
    if (IN(2)) {
        REPS(2) {
        if (F.vcu < 32) { pg8::Gemm g{(const bf16*)(ws + WS_KV), (const bf16*)(ws + WS_W1CT), 1024, 2048, 2048}; ListOrder S{32, F.G, F.vcu, 1, 16};
          EpiF32Half<true> E{(float*)(ws + WS_HID), (const float*)(ws + WS_SMALL + SM_B1C)};
          pg8::gemm_phase<EpiF32Half<true>, ListOrder, true, true>(ring, g, S, E); }
        else expert_transposes(F, args, 32);
        { pg8::Gemm g{(const bf16*)(ws + WS_SA) + 128, (const bf16*)(ws + WS_BPT), 384, 256, 256}; ListOrder S{256, F.G, F.vcu, 1, 8};
          EpiF32Half<false> E{(float*)(ws + WS_E), nullptr};
          pg8::gemm_phase<EpiF32Half<false>, ListOrder, true, true>(ring, g, S, E); }
        }
        if (BOTH(2)) GRID_BAR();
    }
    if (IN(3)) { _Pragma("unroll") REPS(3) { p3_thin(F, args); } if (BOTH(3)) GRID_BAR(); }
    if (IN(4)) {
        REPS(4) {
        { int k384 = 384; asm volatile("" : "+s"(k384));
          pg8::Gemm g{(const bf16*)(ws + WS_SA), (const bf16*)(ws + WS_CT), 384, 384, k384}; ListOrder S{256, F.G, F.vcu, 1, 8};
          EpiS5Y E{(bf16*)(ws + WS_Z)};
          pg8::gemm_phase<EpiS5Y, ListOrder, true, true>(ring, g, S, E); }
        __syncthreads();
        p4_attention(F, args);
        __syncthreads(); }
        if (BOTH(4)) GRID_BAR();
    }
    if (IN(5)) {
        pg8::Gemm g{(const bf16*)(ws + WS_O), (const bf16*)(ws + WS_WAT), 512, 512, 512}; pg8::StaticOrder S; S.init(NTOK, 1024, F.G, (int)blockIdx.x);
        EpiYa E{(bf16*)(ws + WS_T), (const bf16*)(ws + WS_MG)};
        _Pragma("unroll") REPS(5) { pg8::gemm_phase<EpiYa, pg8::StaticOrder, true, true>(ring, g, S, E); }
        if (BOTH(5)) GRID_BAR();
    }
    if (IN(6)) {
        pg8::Gemm g{(const bf16*)(ws + WS_Z), (const bf16*)(ws + WS_WVGT), 512, 512, 512}; pg8::StaticOrder S; S.init(NTOK, 2048, F.G, (int)blockIdx.x);
        EpiYb E{(const bf16*)(ws + WS_T), (const bf16*)(ws + WS_MG), args.in[I_BGATE], (bf16*)(ws + WS_MIX)};
        REPS(6) { pg8::gemm_phase<EpiYb, pg8::StaticOrder, true, true>(ring, g, S, E); }
        if (BOTH(6)) GRID_BAR();
    }
    if (IN(7)) {
        pg8::Gemm g{(const bf16*)(ws + WS_MIX), (const bf16*)(ws + WS_WOT), 1024, 1024, 1024}; pg8::StaticOrder S; S.init(NTOK, 1024, F.G, (int)blockIdx.x);
        EpiOut E{args.in[I_X], (float*)(ws + WS_H1)};
        _Pragma("unroll") REPS(7) { pg8::gemm_phase<EpiOut, pg8::StaticOrder, true, true>(ring, g, S, E); }
        if (BOTH(7)) GRID_BAR();
    }
    if (IN(8)) {
        p8_ln(F, args);
        GRID_BAR();
        { pg8::Gemm g{(const bf16*)(ws + WS_H1B), (const bf16*)(ws + WS_WRT), 1024, 1024, 1024}; RouterOrder S{F.vcu};
          EpiRouter E{args.in[I_RBG], args.in[I_RBE], (int*)(ws + WS_ROUTE), (int*)(ws + WS_HIST)};
          REPS(8) { pg8::gemm_phase<EpiRouter, RouterOrder, false, true, true>(ring, g, S, E); } }
        if (BOTH(8)) GRID_BAR();
    }
    if (IN(9)) { REPS(9) { p9_scatter(F, args); __syncthreads(); } if (BOTH(9)) GRID_BAR(); }
    if (IN(10)) {
        LAS int* pstart = (LAS int*)(F.lds + LTAB_OFF); LAS unsigned char* tile_e = (LAS unsigned char*)(F.lds + LTAB_OFF + 512);
        const int ntiles = moe_tables(F, (const int*)F.ctl + CW_CNT, pstart, tile_e);
        pg8::Gemm g{(const bf16*)(ws + WS_XS), (const bf16*)(ws + WS_WGUT), 1024, 1024, 1024}; MoeOrder S{ntiles * 2, F.G, F.vcu, 2, tile_e};
        EpiMoe1 E{(bf16*)(ws + WS_HB)};
        _Pragma("unroll") REPS(10) { pg8::gemm_phase<EpiMoe1, MoeOrder, true, true>(ring, g, S, E); }
        if (BOTH(10)) GRID_BAR();
    }
    if (IN(11)) {
        LAS int* pstart = (LAS int*)(F.lds + LTAB_OFF); LAS unsigned char* tile_e = (LAS unsigned char*)(F.lds + LTAB_OFF + 512);
        const int ntiles = moe_tables(F, (const int*)F.ctl + CW_CNT, pstart, tile_e);
        int k256 = 256; asm volatile("" : "+s"(k256));
        pg8::Gemm g{(const bf16*)(ws + WS_HB), (const bf16*)(ws + WS_WDT), 256, 256, k256}; MoeOrder S{ntiles * 4, F.G, F.vcu, 4, tile_e};
        EpiMoe2 E{(bf16*)(ws + WS_Y2)};
        _Pragma("unroll") REPS(11) { pg8::gemm_phase<EpiMoe2, MoeOrder, true, true>(ring, g, S, E); }
        if (BOTH(11)) GRID_BAR();
    }
#ifdef PROBE_EXTRA_BARS
    if (IN(12)) { _Pragma("unroll 1") for (int xb = 0; xb < PROBE_EXTRA_BARS; ++xb) GRID_BAR(); }
#endif
    if (IN(12)) { _Pragma("unroll") REPS(12) { p12_final(F, args, args.out); } }
#undef IN
#undef BOTH
}

extern "C" void kernel_launch(void* const* d_in, const int* in_sizes, int n_in, void* d_out, int out_size, void* d_ws, size_t ws_size, hipStream_t stream) {
    static int grid = 0;
    if (grid == 0) {
        if (n_in != 33 || out_size != NTOK * DM || ws_size < WS_END) { fprintf(stderr, "kernel_launch: unexpected problem shape (n_in %d, out %d, ws %zu)\n", n_in, out_size, ws_size); grid = -1; return; }
        int dev = 0, cus = 0, per_cu = 0;
        if (hipGetDevice(&dev) != hipSuccess || hipDeviceGetAttribute(&cus, hipDeviceAttributeMultiprocessorCount, dev) != hipSuccess) { grid = -1; return; }
        if (hipFuncSetAttribute((const void*)fwd, hipFuncAttributeMaxDynamicSharedMemorySize, LDS_BYTES) != hipSuccess) { fprintf(stderr, "kernel_launch: hipFuncSetAttribute failed\n"); grid = -1; return; }
        if (hipOccupancyMaxActiveBlocksPerMultiprocessor(&per_cu, (const void*)fwd, NWAVES * 64, LDS_BYTES) != hipSuccess || per_cu < 1)
            fprintf(stderr, "kernel_launch: occupancy query reports %d workgroups per CU\n", per_cu);
        (void)hipGetLastError();
        grid = cus;
    }
    if (grid < 0) return;
    if (hipMemsetAsync((char*)d_ws + WS_CTL, 0, CTL_ZERO_BYTES, stream) != hipSuccess) return;
    Args a{};
    for (int i = 0; i < 33; ++i) a.in[i] = (const float*)d_in[i];
    a.out = (float*)d_out; a.ws = (unsigned char*)d_ws;
    if (MK_N_LAUNCHES == 1) { a.ph_lo = 0; a.ph_hi = N_PHASES; hipLaunchKernelGGL(fwd, dim3(grid), dim3(NWAVES * 64), LDS_BYTES, stream, a); }
    else for (int li = 0; li < N_PHASES; ++li) { a.ph_lo = li; a.ph_hi = li + 1; hipLaunchKernelGGL(fwd, dim3(grid), dim3(NWAVES * 64), LDS_BYTES, stream, a); }
}
```

```cpp
#include <hip/hip_runtime.h>
#include <cstdio>
#include <cstdint>
#include <cmath>
namespace pg8 {
#define PG8_LAS __attribute__((address_space(3)))
typedef unsigned short bf16_t;
typedef short bf16x8 __attribute__((ext_vector_type(8)));
typedef float f32x4 __attribute__((ext_vector_type(4)));
typedef unsigned u32x4 __attribute__((ext_vector_type(4)));
constexpr int BM = 256, BK = 64, HALF = 128, HTB = HALF * BK * 2  , STAGE_BYTES = 8 * HTB, NXCD = 8, WGM = 8;

__host__ __device__ __forceinline__ int lds_byte(int r, int c) { const int st = (r >> 4) * 2 + (c >> 5), rr = r & 15, cc = c & 31, ob = rr * 64 + cc * 2; return st * 1024 + (ob ^ (((ob >> 9) & 1) << 5)); }
__host__ __device__ __forceinline__ void stage_rc(int b, int& R, int& C) { const int st = b / 1024, sb = b % 1024, swz = sb ^ (((sb >> 9) & 1) << 5); R = (st >> 1) * 16 + swz / 64; C = (st & 1) * 32 + (swz % 64) / 2; }
__host__ __device__ __forceinline__ int perm32(int rho) { const int n = rho >> 4, i = rho & 15; return 8 * (i >> 2) + 4 * n + (i & 3); }

struct Unit { int pm, pn; };
struct Gemm { const bf16_t* A; const bf16_t* Bt; int lda, ldb, K; };

struct StaticOrder {
    int nM, nN, nwg, G, c;
    __host__ __device__ void init(int M, int N, int G_, int c_) { nM = M / BM; nN = N / BM; nwg = nM * nN; G = G_; c = c_; }
    __host__ __device__ bool next(int i, Unit& u) const {
        const long L = (long)i * G + c; if (L >= nwg) return false;
        int wgid = (int)L; { const int q = nwg / NXCD, r = nwg % NXCD, xcd = wgid % NXCD, off = wgid / NXCD; wgid = (xcd < r ? xcd * (q + 1) : r * (q + 1) + (xcd - r) * q) + off; }
        const int nig = WGM * nN, gid = wgid / nig, fm = gid * WGM, gsz = (nM - fm) < WGM ? (nM - fm) : WGM;
        u.pm = fm + ((wgid % nig) % gsz); u.pn = (wgid % nig) / gsz; return true;
    }
    __device__ __forceinline__ void a_ready(const Unit&) const {}
    __device__ __forceinline__ void done(const Unit&) const {}
};

__device__ __forceinline__ unsigned cvt_pk_bf16(float lo, float hi) { unsigned r; asm volatile("v_cvt_pk_bf16_f32 %0, %1, %2" : "=v"(r) : "v"(lo), "v"(hi)); return r; }

template <class Epi, class Sched, bool ALIGN_EPI = false, bool SP2 = false, bool KEEP_ACC = false>
__device__ __forceinline__ void gemm_phase(PG8_LAS unsigned char* lds, const Gemm g, const Sched& S, const Epi& E) {
    const int tid = threadIdx.x, wid = __builtin_amdgcn_readfirstlane(tid >> 6), lane = tid & 63, wr = wid >> 2, wc = wid & 3, fr = lane & 15, fq = lane >> 4;
    const int K = g.K, nt = K / BK;
    unsigned voffA[2], voffB[2];
#pragma unroll
    for (int i = 0; i < 2; ++i) { int R, C; stage_rc(tid * 16 + i * 8192, R, C); const int Rb = Epi::PERM ? ((R & ~31) + perm32(R & 31)) : R;
        voffA[i] = (unsigned)(R * g.lda + C) * 2u; voffB[i] = (unsigned)(Rb * g.ldb + C) * 2u; }
    const size_t kstep = (size_t)(BK * 2);
    const size_t hstepA = (size_t)HALF * g.lda * 2, hstepB = (size_t)HALF * g.ldb * 2;
    const size_t tstepA = 2 * hstepA, tstepB = 2 * hstepB;
    const unsigned ldsw = (unsigned)wid * 1024u;
    const int aoff = lds_byte(wr * 64 + fr, fq * 8), boff = lds_byte(wc * 32 + fr, fq * 8);
#define PG8_SA(b, h) (((b) * 2 + (h)) * HTB)
#define PG8_SB(b, h) ((4 + (b) * 2 + (h)) * HTB)
#define PG8_STAGE(bufoff, gbase, voff) do { _Pragma("unroll") for (int _i = 0; _i < 2; ++_i) \
        __builtin_amdgcn_global_load_lds((const unsigned*)((const char*)(gbase) + (voff)[_i]), (PG8_LAS unsigned*)(lds + (bufoff) + ldsw + _i * 8192), 16, 0, 0); } while (0)
#define PG8_LDA(dst, b, h) do { _Pragma("unroll") for (int m = 0; m < 4; ++m) _Pragma("unroll") for (int k = 0; k < 2; ++k) dst[m][k] = *(const PG8_LAS bf16x8*)(lds + PG8_SA(b, h) + aoff + m * 2048 + k * 1024); } while (0)
#define PG8_LDB(dst, b, h) do { _Pragma("unroll") for (int n = 0; n < 2; ++n) _Pragma("unroll") for (int k = 0; k < 2; ++k) dst[n][k] = *(const PG8_LAS bf16x8*)(lds + PG8_SB(b, h) + boff + n * 2048 + k * 1024); } while (0)
#define PG8_MMA(ai, bj, At, Bt) do { __builtin_amdgcn_s_setprio(1); _Pragma("unroll") for (int m = 0; m < 4; ++m) _Pragma("unroll") for (int n = 0; n < 2; ++n) _Pragma("unroll") for (int k = 0; k < 2; ++k) \
        acc[ai][bj][m][n] = __builtin_amdgcn_mfma_f32_16x16x32_bf16(Bt[n][k], At[m][k], acc[ai][bj][m][n], 0, 0, 0); __builtin_amdgcn_s_setprio(0); } while (0)
#define PG8_WAIT_V(n) asm volatile("s_waitcnt vmcnt(" #n ")" ::: "memory")
#define PG8_WAIT_L(n) asm volatile("s_waitcnt lgkmcnt(" #n ")" ::: "memory")
#define PG8_BAR __builtin_amdgcn_s_barrier()
#define PG8_SCHED __builtin_amdgcn_sched_barrier(0)
    Unit cur, nxt; int ui = 0;
    if (!S.next(0, cur)) return;
    f32x4 acc[2][2][4][2];
#pragma unroll
    for (int a = 0; a < 2; ++a)
#pragma unroll
        for (int b = 0; b < 2; ++b)
#pragma unroll
            for (int m = 0; m < 4; ++m)
#pragma unroll
                for (int n = 0; n < 2; ++n) acc[a][b][m][n] = (f32x4){0.f, 0.f, 0.f, 0.f};
    bf16x8 At[4][2], B0[2][2], B1[2][2];
    const char* cA = (const char*)g.A + (size_t)cur.pm * tstepA; const char* cB = (const char*)g.Bt + (size_t)cur.pn * tstepB;
    S.a_ready(cur);
    if constexpr (SP2) {
        PG8_STAGE(PG8_SB(0, 0), cB, voffB); PG8_STAGE(PG8_SB(0, 1), cB + hstepB, voffB); PG8_STAGE(PG8_SA(0, 0), cA, voffA); PG8_STAGE(PG8_SA(0, 1), cA + hstepA, voffA);
        if (wr == 1) PG8_BAR;
        PG8_WAIT_V(2); PG8_BAR;
        PG8_STAGE(PG8_SB(1, 0), cB + kstep, voffB); PG8_STAGE(PG8_SA(1, 0), cA + kstep, voffA); PG8_STAGE(PG8_SB(1, 1), cB + hstepB + kstep, voffB);
        PG8_WAIT_V(6); PG8_BAR;
    } else {
        PG8_STAGE(PG8_SB(0, 0), cB, voffB); PG8_STAGE(PG8_SA(0, 0), cA, voffA); PG8_STAGE(PG8_SB(0, 1), cB + hstepB, voffB); PG8_STAGE(PG8_SA(0, 1), cA + hstepA, voffA);
        if (wr == 1) PG8_BAR;
        PG8_WAIT_V(4); PG8_BAR;
        PG8_STAGE(PG8_SB(1, 0), cB + kstep, voffB); PG8_STAGE(PG8_SA(1, 0), cA + kstep, voffA); PG8_STAGE(PG8_SB(1, 1), cB + hstepB + kstep, voffB);
        PG8_WAIT_V(6); PG8_BAR;
    }
    for (;;) {
        const bool has_next = S.next(ui + 1, nxt);
        const char* nA = has_next ? (const char*)g.A + (size_t)nxt.pm * tstepA : cA; const char* nB = has_next ? (const char*)g.Bt + (size_t)nxt.pn * tstepB : cB;
        for (int t = 0; t < nt; t += 2) {
            const bool last = (t == nt - 2);
            const char* a1 = cA + (size_t)(t + 1) * kstep;
            const char* a2 = last ? nA : cA + (size_t)(t + 2) * kstep; const char* b2 = last ? nB : cB + (size_t)(t + 2) * kstep;
            const char* a3 = a2 + kstep; const char* b3 = b2 + kstep;
            if (last && has_next) S.a_ready(nxt);
            if constexpr (SP2) {
            PG8_LDB(B0, 0, 0); PG8_LDB(B1, 0, 1); PG8_SCHED; PG8_LDA(At, 0, 0); PG8_STAGE(PG8_SA(1, 1), a1 + hstepA, voffA);
            PG8_WAIT_V(8); PG8_WAIT_L(0); PG8_BAR; PG8_MMA(0, 0, At, B0); PG8_MMA(0, 1, At, B1); PG8_BAR; PG8_SCHED;
            PG8_LDA(At, 0, 1); PG8_STAGE(PG8_SB(0, 0), b2, voffB); PG8_STAGE(PG8_SB(0, 1), b2 + hstepB, voffB); PG8_STAGE(PG8_SA(0, 0), a2, voffA);
            PG8_WAIT_V(8); PG8_WAIT_L(0); PG8_BAR; PG8_MMA(1, 0, At, B0); PG8_MMA(1, 1, At, B1); PG8_BAR; PG8_SCHED;
            PG8_LDB(B0, 1, 0); PG8_LDB(B1, 1, 1); PG8_SCHED; PG8_LDA(At, 1, 0); PG8_STAGE(PG8_SA(0, 1), a2 + hstepA, voffA);
            PG8_WAIT_V(8); PG8_WAIT_L(0); PG8_BAR; PG8_MMA(0, 0, At, B0); PG8_MMA(0, 1, At, B1); PG8_BAR; PG8_SCHED;
            PG8_LDA(At, 1, 1); PG8_STAGE(PG8_SB(1, 0), b3, voffB); PG8_STAGE(PG8_SB(1, 1), b3 + hstepB, voffB); PG8_STAGE(PG8_SA(1, 0), a3, voffA);
            PG8_WAIT_V(8); PG8_WAIT_L(0); PG8_BAR; PG8_MMA(1, 0, At, B0); PG8_MMA(1, 1, At, B1); PG8_BAR; PG8_SCHED;
            } else {
            PG8_LDB(B0, 0, 0); PG8_SCHED; PG8_LDA(At, 0, 0); PG8_STAGE(PG8_SA(1, 1), a1 + hstepA, voffA);
            PG8_WAIT_L(8); PG8_BAR; PG8_WAIT_L(0); PG8_MMA(0, 0, At, B0); PG8_BAR; PG8_SCHED;
            PG8_LDB(B1, 0, 1); PG8_STAGE(PG8_SB(0, 0), b2, voffB);
            PG8_BAR; PG8_WAIT_L(0); PG8_MMA(0, 1, At, B1); PG8_BAR;
            PG8_LDA(At, 0, 1); PG8_STAGE(PG8_SA(0, 0), a2, voffA);
            PG8_BAR; PG8_WAIT_L(0); PG8_MMA(1, 0, At, B0); PG8_BAR; PG8_SCHED;
            PG8_STAGE(PG8_SB(0, 1), b2 + hstepB, voffB);
            PG8_WAIT_V(6); PG8_BAR; PG8_MMA(1, 1, At, B1); PG8_BAR;
            PG8_LDB(B0, 1, 0); PG8_SCHED; PG8_LDA(At, 1, 0); PG8_STAGE(PG8_SA(0, 1), a2 + hstepA, voffA);
            PG8_WAIT_L(8); PG8_BAR; PG8_WAIT_L(0); PG8_MMA(0, 0, At, B0); PG8_BAR; PG8_SCHED;
            PG8_LDB(B1, 1, 1); PG8_STAGE(PG8_SB(1, 0), b3, voffB);
            PG8_BAR; PG8_WAIT_L(0); PG8_MMA(0, 1, At, B1); PG8_BAR;
            PG8_LDA(At, 1, 1); PG8_STAGE(PG8_SA(1, 0), a3, voffA);
            PG8_BAR; PG8_WAIT_L(0); PG8_MMA(1, 0, At, B0); PG8_BAR; PG8_SCHED;
            PG8_STAGE(PG8_SB(1, 1), b3 + hstepB, voffB);
            PG8_WAIT_V(6); PG8_BAR; PG8_MMA(1, 1, At, B1); PG8_BAR;
            }
        }
        if constexpr (ALIGN_EPI) { if (wr == 0) PG8_BAR; }
        if constexpr (!Epi::AFTER_DRAIN) { E(acc, cur, wr, wc, fr, fq); S.done(cur); }
        if (!has_next) break;
        if constexpr (!KEEP_ACC) {
#pragma unroll
        for (int a = 0; a < 2; ++a)
#pragma unroll
            for (int b = 0; b < 2; ++b)
#pragma unroll
                for (int m = 0; m < 4; ++m)
#pragma unroll
                    for (int n = 0; n < 2; ++n) acc[a][b][m][n] = (f32x4){0.f, 0.f, 0.f, 0.f};
        }
        cur = nxt; cA = nA; cB = nB; ++ui;
        if constexpr (ALIGN_EPI) { if (wr == 1) PG8_BAR; }
    }
    PG8_WAIT_V(0);
    if constexpr (!ALIGN_EPI) { if (wr == 0) PG8_BAR; }
    PG8_BAR;
    if constexpr (Epi::AFTER_DRAIN) { E.fused(acc, cur, wr, wc, fr, fq, lds, wid, lane); S.done(cur); }
#undef PG8_SA
#undef PG8_SB
#undef PG8_STAGE
#undef PG8_LDA
#undef PG8_LDB
#undef PG8_MMA
#undef PG8_WAIT_V
#undef PG8_WAIT_L
#undef PG8_BAR
#undef PG8_SCHED
}
}

constexpr int NWAVES = 8;
#ifndef MK_N_LAUNCHES
#define MK_N_LAUNCHES 1
#endif
constexpr int N_PHASES = 13;
constexpr int DM = 1024, NB = 8, SEQ = 4096, NTOK = NB * SEQ;
constexpr int NPROJ = 4096;
constexpr int D_IN = 3864;
constexpr int MOE_CAP = 2 * NTOK + 64 * 256;
constexpr float LN_EPS = 1e-5f;
constexpr float DN_ALPHA = 1.189207115002721f;

constexpr size_t MiB = 1u << 20;
constexpr size_t WS_CTL = 0, CTL_ZERO_BYTES = 64 * 1024;
constexpr size_t WS_SMALL = 1 * MiB;
constexpr size_t WS_WAT = 2 * MiB, WS_WVGT = 3 * MiB, WS_WOT = 5 * MiB, WS_W1CT = 7 * MiB, WS_BPT = 9 * MiB, WS_CT = 13 * MiB;
constexpr size_t WS_ROUTE = 19 * MiB;
constexpr size_t WS_HIST = 1 * MiB + 128 * 1024;
constexpr size_t WS_KC = 20 * MiB;
constexpr size_t WS_HID = 21 * MiB;
constexpr size_t WS_WRT = 25 * MiB;
constexpr size_t WS_WGUT = 26 * MiB, WS_WDT = 90 * MiB;
constexpr size_t WS_MG = 122 * MiB;
constexpr size_t WS_H1 = WS_MG;
constexpr size_t WS_XB = 250 * MiB;
constexpr size_t WS_Z = 250 * MiB, WS_O = 282 * MiB, WS_H1B = 250 * MiB, WS_HB = 250 * MiB;
constexpr size_t WS_Q = 314 * MiB, WS_KV = 346 * MiB, WS_SA = 394 * MiB, WS_G = 442 * MiB, WS_WINT = 444 * MiB, WS_E = 452 * MiB;
constexpr size_t WS_HLO = 314 * MiB;
constexpr size_t WS_T = 314 * MiB;
constexpr size_t WS_MIX = 394 * MiB;
constexpr size_t WS_XS = 314 * MiB, WS_Y2 = 314 * MiB;
constexpr size_t WS_END = 512 * MiB;
static_assert(WS_XS + (size_t)MOE_CAP * 1024 * 2 <= WS_END && WS_HB + (size_t)MOE_CAP * 256 * 2 <= WS_XS, "d_ws map");
constexpr size_t SM_BIASR = 0;
constexpr size_t SM_B1C = 32 * 1024;
constexpr size_t SM_LUT = 40 * 1024;
constexpr size_t SM_A16 = 48 * 1024;
constexpr int CW_CNT = 64, CW_CUR = 128;
constexpr int CW_BAR = 4096;

constexpr int RING_OFF = 0, RING_BYTES = 131072;
constexpr int LDSCTL_OFF = RING_BYTES, MISC_OFF = LDSCTL_OFF + 320;
constexpr int LTAB_OFF = LDSCTL_OFF + 1024;
constexpr int LDS_BYTES = 147456;

#define GAS __attribute__((address_space(1)))
#define LAS __attribute__((address_space(3)))
typedef unsigned short bf16;
typedef unsigned v4u __attribute__((ext_vector_type(4)));
typedef unsigned v2u __attribute__((ext_vector_type(2)));
typedef float f32x4 __attribute__((ext_vector_type(4)));
typedef float f32x2 __attribute__((ext_vector_type(2)));
typedef GAS unsigned gu32;
#define RLX_AGENT __ATOMIC_RELAXED, __HIP_MEMORY_SCOPE_AGENT
#define LDS_WAIT() asm volatile("s_waitcnt lgkmcnt(0)" ::: "memory")
#define VM_WAIT() asm volatile("s_waitcnt vmcnt(0)" ::: "memory")
typedef __bf16 bf16x2_t __attribute__((ext_vector_type(2)));
__device__ __forceinline__ unsigned pk2(float lo, float hi) { const f32x2 v = {lo, hi}; const bf16x2_t b = __builtin_convertvector(v, bf16x2_t); return __builtin_bit_cast(unsigned, b); }
__device__ __forceinline__ float bflo(unsigned w) { return __uint_as_float(w << 16); }
__device__ __forceinline__ float bfhi(unsigned w) { return __uint_as_float(w & 0xffff0000u); }
__device__ __forceinline__ float bf2f(bf16 h) { return __uint_as_float(((unsigned)h) << 16); }
__device__ __forceinline__ float sigmoidf_(float x) { return __builtin_amdgcn_rcpf(1.0f + __expf(-x)); }
__device__ __forceinline__ float gelu_tanh(float x) { const float z2 = x * (1.5957691216057308f + 0.07135481627260025f * x * x); return x * __builtin_amdgcn_rcpf(1.0f + __expf(-z2)); }
__device__ __forceinline__ float wave_sum(float v) {
#pragma unroll
    for (int o = 1; o < 64; o <<= 1) v += __shfl_xor(v, o);
    return v;
}
__device__ __forceinline__ float wave_max(float v) {
#pragma unroll
    for (int o = 1; o < 64; o <<= 1) v = fmaxf(v, __shfl_xor(v, o));
    return v;
}

#define XB_TMO      128
#define XB_XCNT(j)  (256  + 64 * (j))
#define XB_XSUB(j)  (1280 + 64 * (j))
#define XB_XGEN(j)  (2304 + 64 * (j))
#define XB_TOP      3328
#define XB_TOPGEN   3392
#define XCD_BAR_WORDS 3456
#define XB_SPIN_CAP (1u << 18)

__device__ __forceinline__ unsigned xb_ld(unsigned* p)              { return __hip_atomic_load(p, __ATOMIC_RELAXED, __HIP_MEMORY_SCOPE_AGENT); }
__device__ __forceinline__ unsigned xb_add(unsigned* p, unsigned v) { return __hip_atomic_fetch_add(p, v, __ATOMIC_RELAXED, __HIP_MEMORY_SCOPE_AGENT); }
__device__ __forceinline__ unsigned xb_xcc_id() { return (unsigned)__builtin_amdgcn_s_getreg((3 << 11) | 20) & 0xFu; }
#define XB_SPIN(cond, bar) do { unsigned _sp = 0; while (cond) { __builtin_amdgcn_s_sleep(1); \
    if ((++_sp & 255u) == 0u) { if (xb_ld(&(bar)[XB_TMO])) break; if (_sp > XB_SPIN_CAP) { atomicAdd(&(bar)[XB_TMO], 1u); break; } } } } while (0)

struct XcdBarrier {
    unsigned* bar; unsigned x;
    volatile LAS unsigned* st;
};

__device__ __forceinline__ XcdBarrier xcd_barrier_post(unsigned* bar, volatile LAS unsigned* st) {
    XcdBarrier b; b.bar = bar; b.x = xb_xcc_id(); b.st = st;
    if (threadIdx.x == 0) (void)xb_add(&bar[XB_XCNT(b.x)], 1u);
    return b;
}
__device__ __forceinline__ void xcd_barrier_complete(unsigned* bar, unsigned x, unsigned& nloc, unsigned& nx) {
    const unsigned G = gridDim.x * gridDim.y * gridDim.z;
    unsigned sum, cnt, mine, sp = 0u;
    for (;;) {
        sum = 0u; cnt = 0u; mine = 0u;
#pragma unroll
        for (unsigned j = 0; j < 16; ++j) { const unsigned c = xb_ld(&bar[XB_XCNT(j)]); sum += c; cnt += (c > 0u) ? 1u : 0u; mine = (j == x) ? c : mine; }
        if (sum == G) break;
        __builtin_amdgcn_s_sleep(1);
        if ((++sp & 255u) == 0u) { if (xb_ld(&bar[XB_TMO])) break; if (sp > XB_SPIN_CAP) { atomicAdd(&bar[XB_TMO], 1u); break; } }
    }
    nloc = mine > 0u ? mine : 1u; nx = cnt > 0u ? cnt : 1u;
}

__device__ __forceinline__ void xcd_barrier(const XcdBarrier& b) {
    asm volatile("s_waitcnt vmcnt(0)" ::: "memory");
    __syncthreads();
    if (threadIdx.x == 0) {
        unsigned* bar = b.bar;
        __builtin_amdgcn_s_waitcnt(0);
        unsigned nloc = b.st[0], nx = b.st[1];
        if (nloc == 0u) { xcd_barrier_complete(bar, b.x, nloc, nx); b.st[0] = nloc; b.st[1] = nx; }
        const unsigned old = xb_add(&bar[XB_XSUB(b.x)], 1u);
        const unsigned gen = old / nloc;
        if (old + 1u == (gen + 1u) * nloc) {
            __builtin_amdgcn_fence(__ATOMIC_RELEASE, "agent");
            asm volatile("s_waitcnt vmcnt(0)" ::: "memory");
            const unsigned og = xb_add(&bar[XB_TOP], 1u);
            const unsigned tg = og / nx;
            if (og + 1u == (tg + 1u) * nx) xb_add(&bar[XB_TOPGEN], 1u);
            else XB_SPIN(xb_ld(&bar[XB_TOPGEN]) == tg, bar);
            __builtin_amdgcn_fence(__ATOMIC_ACQUIRE, "agent");
            xb_add(&bar[XB_XGEN(b.x)], 1u);
            asm volatile("s_waitcnt vmcnt(0)" ::: "memory");
        } else {
            XB_SPIN(xb_ld(&bar[XB_XGEN(b.x)]) == gen, bar);
            __builtin_amdgcn_fence(__ATOMIC_ACQUIRE, "agent");
            asm volatile("s_waitcnt vmcnt(0)" ::: "memory");
        }
    }
    __syncthreads();
}

struct Frame {
    LAS unsigned char* lds;
    volatile LAS unsigned* MISC;
    gu32* ctl;
    int tid, lane, wave, vcu, G;
    const float* const* in;
    unsigned char* ws;
};
struct Args { const float* in[33]; float* out; unsigned char* ws; int ph_lo, ph_hi; };
enum { I_X = 0, I_RELB, I_WIN, I_BIN, I_CPOS, I_CW1, I_CB1, I_CW2, I_CB2, I_WATT, I_LRE, I_LIM, I_LDT, I_BRE, I_BIM, I_CRE, I_CIM, I_SD, I_WVAL, I_WGATE, I_BGATE, I_WOUT,
       I_LN1G, I_LN1B, I_RWG, I_RBG, I_RWE, I_RBE, I_EWG, I_EWU, I_EWD, I_LN2G, I_LN2B };

struct TrItem { const float* colp; int ldw, k0, K; bf16* wt; };
__device__ __forceinline__ void tr_load(const TrItem& t, float (&tv)[32], int lane) {
#pragma unroll
    for (int i = 0; i < 32; ++i) { const int kk = 2 * i + (lane >> 5); tv[i] = t.colp ? t.colp[(size_t)(t.k0 + kk) * t.ldw] : 0.f; }
}
__device__ __forceinline__ void tr_store(const TrItem& t, const float (&tv)[32], LAS float* scr, int lane) {
#pragma unroll
    for (int i = 0; i < 32; ++i) { const int kk = 2 * i + (lane >> 5); scr[kk * 33 + (lane & 31)] = tv[i]; }
    LDS_WAIT(); asm volatile("" ::: "memory");
    const int c = lane & 7;
#pragma unroll
    for (int j = 0; j < 4; ++j) { const int n = (lane >> 3) + 8 * j; const LAS float* s = scr + (8 * c) * 33 + n;
        v4u o; o.x = pk2(s[0 * 33], s[1 * 33]); o.y = pk2(s[2 * 33], s[3 * 33]); o.z = pk2(s[4 * 33], s[5 * 33]); o.w = pk2(s[6 * 33], s[7 * 33]);
        *(v4u*)(t.wt + (size_t)n * t.K + 8 * c) = o; }
    LDS_WAIT(); asm volatile("" ::: "memory");
}
__device__ __forceinline__ void tr_item(const float* colp, int ldw, int k0, bf16* wt_row0  , int K, LAS float* scr, int lane) {
    const TrItem t{colp, ldw, k0, K, wt_row0}; float tv[32]; tr_load(t, tv, lane); tr_store(t, tv, scr, lane);
}
__device__ __forceinline__ int proj_src_col(int n) {
    return n < 1280 ? n : (n < 3840 ? n + 24 : (n < 3864 ? n - 3840 + 1280 : -1));
}
__device__ __forceinline__ int t5_bucket(int n) {
    if (n < 16) return n;
    const float nf = (float)n;
    int large = 16 + (int)(logf(nf / 16.0f) / 2.0794415416798357f * 16.0f);
    return large < 31 ? large : 31;
}
__device__ __forceinline__ void p0_prologue(Frame& F, const Args& A) {
    unsigned char* ws = F.ws;
    const int gw = F.vcu * NWAVES + F.wave, NGW = F.G * NWAVES, lane = F.lane;
    if (F.vcu < 32) {
        const int g = F.vcu, tid = F.tid;
        LAS float* pwr = (LAS float*)(F.lds);
        LAS float* pwi = pwr + 17 * 64;
        LAS float* bbr = pwi + 17 * 64;
        LAS float* bbi = bbr + 1024;
        LAS float* ccr = bbi + 1024;
        LAS float* cci = ccr + 1024;
        LAS float* kk  = cci + 1024;
        LAS float* fre = kk + 4096;
        if (tid < 64) {
            const int p = tid; const float lr = A.in[I_LRE][g * 64 + p], li = A.in[I_LIM][g * 64 + p], dt = expf(A.in[I_LDT][g]);
            for (int k = 0; k <= 16; ++k) { const float mag = expf((float)k * lr * dt), ang = (float)k * li * dt; pwr[k * 64 + p] = mag * cosf(ang); pwi[k * 64 + p] = mag * sinf(ang); }
            const float mag = expf(lr * dt), abr = mag * cosf(li * dt), abi = mag * sinf(li * dt), nr = abr - 1.0f, ni = abi, den = lr * lr + li * li;
            fre[p] = (nr * lr + ni * li) / den; fre[64 + p] = (ni * lr - nr * li) / den;
            float* a16 = (float*)(ws + WS_SMALL + SM_A16) + (size_t)(g * 64 + p) * 2; a16[0] = pwr[16 * 64 + p]; a16[1] = pwi[16 * 64 + p];
        }
        __syncthreads();
        for (int e = tid; e < 1024; e += 512) { const int p = e >> 4; const float br = A.in[I_BRE][g * 1024 + e], bi = A.in[I_BIM][g * 1024 + e], fr = fre[p], fi = fre[64 + p];
            bbr[e] = fr * br - fi * bi; bbi[e] = fr * bi + fi * br; ccr[e] = A.in[I_CRE][g * 1024 + e]; cci[e] = A.in[I_CIM][g * 1024 + e]; }
        __syncthreads();
        for (int e = tid; e < 4096; e += 512) { const int d = e >> 8, h = (e >> 4) & 15, h2 = e & 15; float s = 0.f;
            for (int p = 0; p < 64; ++p) { const float cr = ccr[h * 64 + p], ci = cci[h * 64 + p], ar = pwr[d * 64 + p], ai = pwi[d * 64 + p], br = bbr[p * 16 + h2], bi = bbi[p * 16 + h2];
                const float tr = cr * ar - ci * ai, ti = cr * ai + ci * ar; s += tr * br - ti * bi; }
            if (d == 0 && h == h2) s += A.in[I_SD][g * 16 + h];
            kk[e] = s; }
        __syncthreads();
        bf16* CT = (bf16*)(ws + WS_CT) + (size_t)g * 256 * 384;
        for (int v = tid; v < 256 * 48; v += 512) { const int n = v / 48, k0 = (v % 48) * 8, tau = n >> 4, h = n & 15; float o[8];
#pragma unroll
            for (int i = 0; i < 8; ++i) { const int k = k0 + i;
                if (k < 128) { const int p = k & 63; const float cr = ccr[h * 64 + p], ci = cci[h * 64 + p], ar = pwr[(tau + 1) * 64 + p], ai = pwi[(tau + 1) * 64 + p];
                    o[i] = (k < 64) ? (cr * ar - ci * ai) : -(cr * ai + ci * ar); }
                else { const int s = (k - 128) >> 4, h2 = (k - 128) & 15; o[i] = (s <= tau) ? kk[((tau - s) << 8) + (h << 4) + h2] : 0.f; } }
            v4u w; w.x = pk2(o[0], o[1]); w.y = pk2(o[2], o[3]); w.z = pk2(o[4], o[5]); w.w = pk2(o[6], o[7]);
            *(v4u*)(CT + (size_t)n * 384 + k0) = w; }
        bf16* BPT = (bf16*)(ws + WS_BPT) + (size_t)g * 256 * 256;
        for (int v = tid; v < 256 * 32; v += 512) { const int n = v >> 5, k0 = (v & 31) * 8; float o[8];
#pragma unroll
            for (int i = 0; i < 8; ++i) { const int k = k0 + i, s = k >> 4, h2 = k & 15;
                if (n < 128) { const int p = n & 63; const float ar = pwr[(15 - s) * 64 + p], ai = pwi[(15 - s) * 64 + p], br = bbr[p * 16 + h2], bi = bbi[p * 16 + h2];
                    o[i] = (n < 64) ? (ar * br - ai * bi) : (ar * bi + ai * br); }
                else o[i] = 0.f; }
            v4u w; w.x = pk2(o[0], o[1]); w.y = pk2(o[2], o[3]); w.z = pk2(o[4], o[5]); w.w = pk2(o[6], o[7]);
            *(v4u*)(BPT + (size_t)n * 256 + k0) = w; }
        __syncthreads();
    }
    {
        const int gt = F.vcu * (NWAVES * 64) + F.tid;
        float* biasr = (float*)(ws + WS_SMALL + SM_BIASR);
        if (gt < NPROJ) { const int sc = proj_src_col(gt); biasr[gt] = sc >= 0 ? A.in[I_BIN][sc] : 0.f; }
        float* lut = (float*)(ws + WS_SMALL + SM_LUT);
        if (gt >= 8192 && gt < 8192 + 1024) { const int e = gt - 8192, dist = e >> 3, h = e & 7; lut[e] = A.in[I_RELB][t5_bucket(dist) * 8 + h]; }
        bf16* wr = (bf16*)(ws + WS_WRT);
        for (int e = gt; e < 512 * 1024; e += F.G * NWAVES * 64) { const int r = e >> 10, k = e & 1023; int n = -1, lo = 0;
            if (r < 72) n = r; else if (r >= 128 && r < 200) { n = r - 128; lo = 1; } else if (r >= 256 && r < 328) n = r - 256;
            float o = 0.f;
            if (n >= 0) { const float w = n < 8 ? A.in[I_RWG][k * 8 + n] : A.in[I_RWE][k * 64 + (n - 8)]; const float hi = __uint_as_float(pk2(w, 0.f) << 16); o = lo ? w - hi : w; }
            wr[e] = (bf16)(pk2(o, 0.f) & 0xffffu); }
        if (gw >= 1024 && gw < 1024 + 256) { const int o = gw - 1024, j = o >> 7, c = o & 127; float s = 0.f;
            for (int i = lane; i < 2048; i += 64) s += A.in[I_CPOS][j * 2048 + i] * A.in[I_CW1][((size_t)j * 2048 + i) * 128 + c];
            s = wave_sum(s); if (lane == 0) ((float*)(ws + WS_SMALL + SM_B1C))[o] = s + A.in[I_CB1][o]; }
    }
    {
        LAS float* scr = (LAS float*)(F.lds + RING_OFF + 32768 + F.wave * 8704);
        constexpr int I_WI = 16 * 128, I_WA = 8 * 32, I_WV = 8 * 64, I_WO = 16 * 32, I_W1 = 2 * 32 * 8;
        constexpr int NITEMS = I_WI + I_WA + I_WV + I_WO + I_W1;
        const int nl = lane & 31;
        for (int it = gw; it < NITEMS; it += NGW) {
            int r = it;
            if (r < I_WI) { const int kb = r / 128, nb = r % 128, n = nb * 32 + nl, sc = proj_src_col(n);
                tr_item(sc >= 0 ? A.in[I_WIN] + sc : nullptr, D_IN, kb * 64, (bf16*)(ws + WS_WINT) + (size_t)(nb * 32) * 1024 + kb * 64, 1024, scr, lane); continue; } r -= I_WI;
            if (r < I_WA) { const int kb = r / 32, nb = r % 32, n = nb * 32 + nl;
                tr_item(A.in[I_WATT] + n, 1024, kb * 64, (bf16*)(ws + WS_WAT) + (size_t)(nb * 32) * 512 + kb * 64, 512, scr, lane); continue; } r -= I_WA;
            if (r < I_WV) { const int kb = r / 64, nb = r % 64, n = nb * 32 + nl, pn = n >> 8, rr = n & 255;
                const float* src = (rr < 128 ? A.in[I_WVAL] : A.in[I_WGATE]) + pn * 128 + (rr & 127);
                tr_item(src, 1024, kb * 64, (bf16*)(ws + WS_WVGT) + (size_t)(nb * 32) * 512 + kb * 64, 512, scr, lane); continue; } r -= I_WV;
            if (r < I_WO) { const int kb = r / 32, nb = r % 32, n = nb * 32 + nl;
                tr_item(A.in[I_WOUT] + n, 1024, kb * 64, (bf16*)(ws + WS_WOT) + (size_t)(nb * 32) * 1024 + kb * 64, 1024, scr, lane); continue; } r -= I_WO;
            if (r < I_W1) { const int j = r / 256, q = r % 256, kb = q / 8, nb = q % 8, n = nb * 32 + nl;
                tr_item(n < 128 ? A.in[I_CW1] + (size_t)j * 2048 * 128 + n : nullptr, 128, kb * 64, (bf16*)(ws + WS_W1CT) + ((size_t)j * 256 + nb * 32) * 2048 + kb * 64, 2048, scr, lane); }
        }
    }
#pragma unroll 2
    for (int m = gw; m < NTOK; m += NGW) {
        const f32x4* xr = (const f32x4*)(A.in[I_X] + (size_t)m * DM) + lane; v2u* o8 = (v2u*)((bf16*)(ws + WS_XB) + (size_t)m * DM) + lane;
#pragma unroll
        for (int j = 0; j < 4; ++j) { const f32x4 v = xr[64 * j]; v2u w; w.x = pk2(v.x, v.y); w.y = pk2(v.z, v.w); o8[64 * j] = w; }
    }
}

__device__ __forceinline__ TrItem expert_item(const Args& A, unsigned char* ws, int r, int nl) {
    constexpr int I_GU = 64 * 256;
    if (r < I_GU) { const int e = r / 256, q = r % 256, kb = q / 16, nb = q % 16, n = nb * 32 + nl, pn = n >> 8, rr = n & 255;
        const float* src = (rr < 128 ? A.in[I_EWG] : A.in[I_EWU]) + (size_t)e * 1024 * 256 + pn * 128 + (rr & 127);
        return TrItem{src, 256, kb * 64, 1024, (bf16*)(ws + WS_WGUT) + ((size_t)e * 512 + nb * 32) * 1024 + kb * 64}; }
    r -= I_GU;
    const int e = r / 128, q = r % 128, kb = q / 32, nb = q % 32, n = nb * 32 + nl;
    return TrItem{A.in[I_EWD] + (size_t)e * 256 * 1024 + n, 1024, kb * 64, 256, (bf16*)(ws + WS_WDT) + ((size_t)e * 1024 + nb * 32) * 256 + kb * 64};
}
__device__ __forceinline__ void expert_transposes(Frame& F, const Args& A, int wg0) {
    unsigned char* ws = F.ws; const int lane = F.lane, nl = lane & 31;
    LAS float* scr = (LAS float*)(F.lds + RING_OFF + F.wave * 8704);
    constexpr int NIT = 64 * 256 + 64 * 128;
    const int gw = (F.vcu - wg0) * NWAVES + F.wave, NGW = (F.G - wg0) * NWAVES;
    float ta[32], tb[32];
    int it = gw;
    if (it < NIT) { TrItem cur = expert_item(A, ws, it, nl); tr_load(cur, ta, lane);
#pragma unroll 1
        for (;;) {
            const int it2 = it + NGW; TrItem nxt = cur;
            if (it2 < NIT) { nxt = expert_item(A, ws, it2, nl); tr_load(nxt, tb, lane); }
            tr_store(cur, ta, scr, lane);
            if (it2 >= NIT) break;
            const int it3 = it2 + NGW; cur = nxt;
            if (it3 < NIT) { cur = expert_item(A, ws, it3, nl); tr_load(cur, ta, lane); }
            tr_store(nxt, tb, scr, lane);
            if (it3 >= NIT) break;
            it = it3;
        }
    }
    __syncthreads();
}

typedef pg8::f32x4 (AccT)[2][2][4][2];
constexpr float QSCALE = 0.125f * 1.4426950408889634f;
struct EpiProj {
    static constexpr bool PERM = true, AFTER_DRAIN = false;
    bf16 *Q, *KV, *SA, *MG, *G; const float* bias;
    __device__ __forceinline__ void operator()(const AccT& acc, const pg8::Unit& u, int wr, int wc, int fr, int fq) const {
        const int pn = u.pn, row0 = u.pm * 256 + wr * 64 + fr;
#pragma unroll
        for (int bj = 0; bj < 2; ++bj) {
            const int cl = bj * 128 + wc * 32 + 8 * fq, nc = pn * 256 + cl;
            const f32x4 b0 = *(const f32x4*)(bias + nc), b1 = *(const f32x4*)(bias + nc + 4);
#pragma unroll
            for (int ai = 0; ai < 2; ++ai)
#pragma unroll
                for (int m = 0; m < 4; ++m) {
                    const int row = row0 + ai * 128 + m * 16;
                    f32x4 v0 = acc[ai][bj][m][0] + b0, v1 = acc[ai][bj][m][1] + b1;
                    bf16* dst;
                    if (pn < 2) { v0 = v0 * QSCALE; v1 = v1 * QSCALE; dst = Q + (size_t)row * 512 + nc; }
                    else if (pn < 5) { const int kc = nc - 512, j = kc >> 7, g = (kc >> 6) & 1, d = kc & 63, b = row >> 12, t = row & 4095; dst = KV + ((((size_t)j * 8 + b) * 2 + g) * 4096 + t) * 64 + d; }
                    else if (pn < 7) { const int uc = nc - 1280, grp = uc >> 4, h = uc & 15, b = row >> 12, t = row & 4095; dst = SA + ((size_t)grp * 2048 + b * 256 + (t >> 4)) * 384 + 128 + (t & 15) * 16 + h; }
                    else {
                        v0.x = sigmoidf_(v0.x); v0.y = sigmoidf_(v0.y); v0.z = sigmoidf_(v0.z); v0.w = sigmoidf_(v0.w);
                        v1.x = sigmoidf_(v1.x); v1.y = sigmoidf_(v1.y); v1.z = sigmoidf_(v1.z); v1.w = sigmoidf_(v1.w);
                        if (pn < 15) dst = MG + (size_t)row * 2048 + (nc - 1792);
                        else { if (cl >= 24) continue; dst = G + (size_t)row * 32 + cl; }
                    }
                    v4u w; w.x = pk2(v0.x, v0.y); w.y = pk2(v0.z, v0.w); w.z = pk2(v1.x, v1.y); w.w = pk2(v1.z, v1.w);
                    *(v4u*)dst = w;
                }
        }
    }
};
template <bool GELU> struct EpiF32Half {
    static constexpr bool PERM = false, AFTER_DRAIN = false;
    float* O; const float* bias;
    __device__ __forceinline__ void operator()(const AccT& acc, const pg8::Unit& u, int wr, int wc, int fr, int fq) const {
        const int row0 = u.pm * 256 + wr * 64 + fr;
#pragma unroll
        for (int n = 0; n < 2; ++n) {
            const int c = wc * 32 + 16 * n + 4 * fq;
            f32x4 bv = (f32x4){0.f, 0.f, 0.f, 0.f}; if (bias) bv = *(const f32x4*)(bias + u.pn * 128 + c);
#pragma unroll
            for (int ai = 0; ai < 2; ++ai)
#pragma unroll
                for (int m = 0; m < 4; ++m) { f32x4 v = acc[ai][0][m][n] + bv;
                    if (GELU) { v.x = gelu_tanh(v.x); v.y = gelu_tanh(v.y); v.z = gelu_tanh(v.z); v.w = gelu_tanh(v.w); }
                    *(f32x4*)(O + (size_t)(row0 + ai * 128 + m * 16) * 128 + c) = v; }
        }
    }
};
struct EpiS5Y {
    static constexpr bool PERM = true, AFTER_DRAIN = false;
    bf16* Z;
    __device__ __forceinline__ void operator()(const AccT& acc, const pg8::Unit& u, int wr, int wc, int fr, int fq) const {
        const int g = u.pn, b = u.pm & 7, ch0 = wr * 64 + fr;
#pragma unroll
        for (int bj = 0; bj < 2; ++bj) { const int n0 = bj * 128 + wc * 32 + 8 * fq, tau = n0 >> 4, h = n0 & 15;
            bf16* zp = Z + ((size_t)b * 4096 + ch0 * 16 + tau) * 512 + g * 16 + h;
#pragma unroll
            for (int ai = 0; ai < 2; ++ai)
#pragma unroll
                for (int m = 0; m < 4; ++m) {
                    const f32x4 v0 = acc[ai][bj][m][0], v1 = acc[ai][bj][m][1];
                    v4u w; w.x = pk2(gelu_tanh(v0.x), gelu_tanh(v0.y)); w.y = pk2(gelu_tanh(v0.z), gelu_tanh(v0.w)); w.z = pk2(gelu_tanh(v1.x), gelu_tanh(v1.y)); w.w = pk2(gelu_tanh(v1.z), gelu_tanh(v1.w));
                    *(v4u*)(zp + (size_t)(ai * 128 + m * 16) * 16 * 512) = w; asm volatile("" ::: "memory"); } }
    }
};
struct EpiYa {
    static constexpr bool PERM = true, AFTER_DRAIN = false;
    bf16* T; const bf16* MG;
    __device__ __forceinline__ void operator()(const AccT& acc, const pg8::Unit& u, int wr, int wc, int fr, int fq) const {
        const int row0 = u.pm * 256 + wr * 64 + fr;
#pragma unroll
        for (int bj = 0; bj < 2; ++bj) { const int col = u.pn * 256 + bj * 128 + wc * 32 + 8 * fq;
#pragma unroll
            for (int ai = 0; ai < 2; ++ai)
#pragma unroll
                for (int m = 0; m < 4; ++m) { const int row = row0 + ai * 128 + m * 16;
                    const v4u g = *(const v4u*)(MG + (size_t)row * 2048 + col); const f32x4 v0 = acc[ai][bj][m][0], v1 = acc[ai][bj][m][1];
                    v4u w; w.x = pk2(v0.x * bflo(g.x), v0.y * bfhi(g.x)); w.y = pk2(v0.z * bflo(g.y), v0.w * bfhi(g.y)); w.z = pk2(v1.x * bflo(g.z), v1.y * bfhi(g.z)); w.w = pk2(v1.z * bflo(g.w), v1.w * bfhi(g.w));
                    *(v4u*)(T + (size_t)row * 1024 + col) = w; } }
    }
};
struct EpiYb {
    static constexpr bool PERM = true, AFTER_DRAIN = false;
    const bf16* T; const bf16* MG; const float* bg; bf16* MX;
    __device__ __forceinline__ void operator()(const AccT& acc, const pg8::Unit& u, int wr, int wc, int fr, int fq) const {
        const int row0 = u.pm * 256 + wr * 64 + fr, col = u.pn * 128 + wc * 32 + 8 * fq;
        const f32x4 b0 = *(const f32x4*)(bg + col), b1 = *(const f32x4*)(bg + col + 4);
#pragma unroll
        for (int ai = 0; ai < 2; ++ai)
#pragma unroll
            for (int m = 0; m < 4; ++m) { const int row = row0 + ai * 128 + m * 16;
                const v4u g = *(const v4u*)(MG + (size_t)row * 2048 + 1024 + col); const v4u t = *(const v4u*)(T + (size_t)row * 1024 + col);
                const f32x4 a0 = acc[ai][0][m][0], a1 = acc[ai][0][m][1], g0 = acc[ai][1][m][0] + b0, g1 = acc[ai][1][m][1] + b1;
                float o[8];
                o[0] = bflo(t.x) + bflo(g.x) * a0.x * sigmoidf_(g0.x); o[1] = bfhi(t.x) + bfhi(g.x) * a0.y * sigmoidf_(g0.y);
                o[2] = bflo(t.y) + bflo(g.y) * a0.z * sigmoidf_(g0.z); o[3] = bfhi(t.y) + bfhi(g.y) * a0.w * sigmoidf_(g0.w);
                o[4] = bflo(t.z) + bflo(g.z) * a1.x * sigmoidf_(g1.x); o[5] = bfhi(t.z) + bfhi(g.z) * a1.y * sigmoidf_(g1.y);
                o[6] = bflo(t.w) + bflo(g.w) * a1.z * sigmoidf_(g1.z); o[7] = bfhi(t.w) + bfhi(g.w) * a1.w * sigmoidf_(g1.w);
                v4u w; w.x = pk2(o[0], o[1]); w.y = pk2(o[2], o[3]); w.z = pk2(o[4], o[5]); w.w = pk2(o[6], o[7]);
                *(v4u*)(MX + (size_t)row * 1024 + col) = w; }
    }
};
struct EpiOut {
    static constexpr bool PERM = false, AFTER_DRAIN = false;
    const float* X; float* V;
    __device__ __forceinline__ void operator()(const AccT& acc, const pg8::Unit& u, int wr, int wc, int fr, int fq) const {
        const int row0 = u.pm * 256 + wr * 64 + fr;
#pragma unroll
        for (int bj = 0; bj < 2; ++bj)
#pragma unroll
            for (int n = 0; n < 2; ++n) { const int col = u.pn * 256 + bj * 128 + wc * 32 + 16 * n + 4 * fq;
#pragma unroll
                for (int ai = 0; ai < 2; ++ai)
#pragma unroll
                    for (int m = 0; m < 4; ++m) { const size_t o = (size_t)(row0 + ai * 128 + m * 16) * 1024 + col;
                        const f32x4 x = *(const f32x4*)(X + o); *(f32x4*)(V + o) = x * DN_ALPHA + acc[ai][bj][m][n]; } }
    }
};
struct EpiMoe1 {
    static constexpr bool PERM = true, AFTER_DRAIN = false;
    bf16* HB;
    __device__ __forceinline__ void operator()(const AccT& acc, const pg8::Unit& u, int wr, int wc, int fr, int fq) const {
        const int row0 = u.pm * 256 + wr * 64 + fr, col = (u.pn & 1) * 128 + wc * 32 + 8 * fq;
#pragma unroll
        for (int ai = 0; ai < 2; ++ai)
#pragma unroll
            for (int m = 0; m < 4; ++m) { const f32x4 g0 = acc[ai][0][m][0], g1 = acc[ai][0][m][1], u0 = acc[ai][1][m][0], u1 = acc[ai][1][m][1];
                v4u w; w.x = pk2(g0.x * sigmoidf_(g0.x) * u0.x, g0.y * sigmoidf_(g0.y) * u0.y); w.y = pk2(g0.z * sigmoidf_(g0.z) * u0.z, g0.w * sigmoidf_(g0.w) * u0.w);
                w.z = pk2(g1.x * sigmoidf_(g1.x) * u1.x, g1.y * sigmoidf_(g1.y) * u1.y); w.w = pk2(g1.z * sigmoidf_(g1.z) * u1.z, g1.w * sigmoidf_(g1.w) * u1.w);
                *(v4u*)(HB + (size_t)(row0 + ai * 128 + m * 16) * 256 + col) = w; }
    }
};
struct EpiMoe2 {
    static constexpr bool PERM = true, AFTER_DRAIN = false;
    bf16* Y;
    __device__ __forceinline__ void operator()(const AccT& acc, const pg8::Unit& u, int wr, int wc, int fr, int fq) const {
        const int row0 = u.pm * 256 + wr * 64 + fr;
#pragma unroll
        for (int bj = 0; bj < 2; ++bj) { const int col = (u.pn & 3) * 256 + bj * 128 + wc * 32 + 8 * fq;
#pragma unroll
            for (int ai = 0; ai < 2; ++ai)
#pragma unroll
                for (int m = 0; m < 4; ++m) { const f32x4 v0 = acc[ai][bj][m][0], v1 = acc[ai][bj][m][1];
                    v4u w; w.x = pk2(v0.x, v0.y); w.y = pk2(v0.z, v0.w); w.z = pk2(v1.x, v1.y); w.w = pk2(v1.z, v1.w);
                    *(v4u*)(Y + (size_t)(row0 + ai * 128 + m * 16) * 1024 + col) = w; } }
    }
};
struct EpiRouter {
    static constexpr bool PERM = false, AFTER_DRAIN = true;
    const float* bg; const float* be; int* route; int* hist;
    __device__ __forceinline__ void fused(const AccT& acc, const pg8::Unit& u, int wr, int wc, int fr, int fq, PG8_LAS unsigned char* lds, int wid, int lane) const {
        PG8_LAS float* LG = (PG8_LAS float*)lds;
        PG8_LAS int* lh = (PG8_LAS int*)(lds + 256 * 76 * 4);
        const int tid = wid * 64 + lane;
        if (tid < 64) lh[tid] = 0;
        if (wc < 3) {
#pragma unroll
            for (int n = 0; n < 2; ++n) { const int c = wc * 32 + 16 * n + 4 * fq;
                if (c < 72) {
#pragma unroll
                    for (int ai = 0; ai < 2; ++ai)
#pragma unroll
                        for (int m = 0; m < 4; ++m) { const pg8::f32x4 v = acc[ai][0][m][n] + acc[ai][1][m][n]; *(PG8_LAS pg8::f32x4*)(LG + (ai * 128 + wr * 64 + m * 16 + fr) * 76 + c) = v; } } }
        }
        asm volatile("s_waitcnt lgkmcnt(0)" ::: "memory"); __builtin_amdgcn_s_barrier(); asm volatile("" ::: "memory");
        const int wg = u.pm - 128;
        if (tid < 256) {
            const PG8_LAS float* l = LG + tid * 76; const int row = wg * 256 + tid;
            float gm = -3.0e38f; int gi = 0; float gl[8];
#pragma unroll
            for (int j = 0; j < 8; ++j) { gl[j] = l[j] + bg[j]; if (gl[j] > gm) { gm = gl[j]; gi = j; } }
            float ge = 0.f;
#pragma unroll
            for (int j = 0; j < 8; ++j) ge += __expf(gl[j] - gm);
            const float pgroup = 1.0f / ge;
            float m1 = -3.0e38f, m2 = -3.0e38f; int i1 = 0, i2 = 0;
#pragma unroll
            for (int j = 0; j < 8; ++j) { const float v = l[8 + gi * 8 + j] + be[gi * 8 + j];
                if (v > m1) { m2 = m1; i2 = i1; m1 = v; i1 = j; } else if (v > m2) { m2 = v; i2 = j; } }
            const float e2 = __expf(m2 - m1), w1 = pgroup / (1.0f + e2), w2 = pgroup * e2 / (1.0f + e2);
            int* rt = route + (size_t)row * 8; const int ex1 = gi * 8 + i1, ex2 = gi * 8 + i2;
            const int r1 = __hip_atomic_fetch_add(lh + ex1, 1, __ATOMIC_RELAXED, __HIP_MEMORY_SCOPE_WORKGROUP), r2 = __hip_atomic_fetch_add(lh + ex2, 1, __ATOMIC_RELAXED, __HIP_MEMORY_SCOPE_WORKGROUP);
            rt[0] = ex1; rt[1] = ex2; rt[2] = __float_as_int(w1); rt[3] = __float_as_int(w2); rt[4] = r1; rt[5] = r2;
        }
        asm volatile("s_waitcnt lgkmcnt(0)" ::: "memory"); __builtin_amdgcn_s_barrier(); asm volatile("" ::: "memory");
        if (tid < 64) hist[wg * 64 + tid] = lh[tid];
    }
};
struct RouterOrder {
    int c;
    __device__ __forceinline__ bool next(int i, pg8::Unit& u) const { if (c >= 128 || i >= 2) return false; u.pm = c + 128 * i; u.pn = i; return true; }
    __device__ __forceinline__ void a_ready(const pg8::Unit&) const {}
    __device__ __forceinline__ void done(const pg8::Unit&) const {}
};
struct ListOrder {
    int n, G, c, per, div;
    __device__ __forceinline__ bool next(int i, pg8::Unit& u) const { const int L = i * G + c; if (L >= n) return false; u.pm = L / per; u.pn = (u.pm / div) * per + L % per; return true; }
    __device__ __forceinline__ void a_ready(const pg8::Unit&) const {}
    __device__ __forceinline__ void done(const pg8::Unit&) const {}
};
struct MoeOrder {
    int n, G, c, per; const LAS unsigned char* tile_e;
    __device__ __forceinline__ bool next(int i, pg8::Unit& u) const { const int L = i * G + c; if (L >= n) return false; u.pm = L / per; u.pn = (int)tile_e[u.pm] * per + L % per; return true; }
    __device__ __forceinline__ void a_ready(const pg8::Unit&) const {}
    __device__ __forceinline__ void done(const pg8::Unit&) const {}
};

__device__ __forceinline__ void p3_thin(Frame& F, const Args& A) {
    unsigned char* ws = F.ws;
    {
        const float* HID = (const float*)(ws + WS_HID); bf16* KC = (bf16*)(ws + WS_KC);
        const int total = 2 * 4096 * 64;
        for (int o = F.vcu * 512 + F.tid; o < total; o += F.G * 512) {
            const int d = o & 63, row = o >> 6, j = row >> 12;
            const float* h = HID + (size_t)row * 128; const float* w = A.in[I_CW2] + (size_t)j * 128 * 64 + d;
            float s = A.in[I_CB2][j * 64 + d];
#pragma unroll 8
            for (int m = 0; m < 128; ++m) s += h[m] * w[m * 64];
            KC[o] = (bf16)(pk2(s, 0.f) & 0xffffu);
        }
    }
    if (F.wave == 0) {
        for (int gb = F.vcu; gb < 256; gb += F.G) {
            const int p = F.lane; const float* a16 = (const float*)(ws + WS_SMALL + SM_A16) + (size_t)((gb >> 3) * 64 + p) * 2; const float ar = a16[0], ai = a16[1];
            const float* E = (const float*)(ws + WS_E) + (size_t)gb * 256 * 128; bf16* SA = (bf16*)(ws + WS_SA) + (size_t)gb * 256 * 384;
            float xr = 0.f, xi = 0.f;
            for (int c0 = 0; c0 < 256; c0 += 8) {
                float er[8], ei[8];
#pragma unroll
                for (int k = 0; k < 8; ++k) { er[k] = E[(size_t)(c0 + k) * 128 + p]; ei[k] = E[(size_t)(c0 + k) * 128 + 64 + p]; }
#pragma unroll
                for (int k = 0; k < 8; ++k) { bf16* row = SA + (size_t)(c0 + k) * 384; row[p] = (bf16)(pk2(xr, 0.f) & 0xffffu); row[64 + p] = (bf16)(pk2(xi, 0.f) & 0xffffu);
                    const float nr = ar * xr - ai * xi + er[k], ni = ar * xi + ai * xr + ei[k]; xr = nr; xi = ni; }
            }
        }
    }
}


namespace att2 {
#ifndef PROBE_SECTION
#define PROBE_SECTION 0
#endif
#define TSEC_BEGIN(id) unsigned long long t_sec_ = 0; if (PROBE_SECTION == (id)) t_sec_ = __builtin_amdgcn_s_memtime()
#define TSEC_END(id, P) do { if (PROBE_SECTION == (id)) (P).tacc += __builtin_amdgcn_s_memtime() - t_sec_; } while (0)
typedef short bf16x8 __attribute__((ext_vector_type(8)));
typedef short s16x4 __attribute__((ext_vector_type(4)));
typedef float f32x16 __attribute__((ext_vector_type(16)));
typedef short v4i16_t __attribute__((ext_vector_type(4)));
typedef LAS const char* lds_cptr;
#define A2_MFMA(a, b, c) __builtin_amdgcn_mfma_f32_32x32x16_bf16(a, b, c, 0, 0, 0)
constexpr int SLOTB = 8192, NSLOT = 4, L_K = 0, L_V = NSLOT * SLOTB, L_LUT = 2 * NSLOT * SLOTB, L_WS = L_LUT + 4096, WS_PER_WAVE = 7168;
constexpr int W_WSF = 0, W_TBL = 128, W_GATE = 256, W_IMP = 768, W_OST = 3072;
static_assert(L_WS + 8 * WS_PER_WAVE <= 131072, "attention LDS map");
constexpr float MASKED = -2.0e30f, MINIT = -1.0e30f, THR = 8.0f;
__device__ __forceinline__ int crow(int r, int hi) { return (r & 3) + 8 * (r >> 2) + 4 * hi; }
__device__ __forceinline__ s16x4 vtr(lds_cptr p) { return __builtin_bit_cast(s16x4, __builtin_amdgcn_ds_read_tr16_b64_v4i16((LAS v4i16_t*)p)); }
#define A2_MX3(a, b, c) __builtin_fmaxf(__builtin_fmaxf((a), (b)), (c))
__device__ __forceinline__ float rowmax(const f32x16& p0, const f32x16& p1) {
    float a = A2_MX3(p0[0], p0[1], p1[0]), b = A2_MX3(p0[2], p0[3], p1[1]); a = A2_MX3(a, p1[2], p1[3]);
#pragma unroll
    for (int r = 4; r < 16; r += 4) { a = A2_MX3(a, p0[r], p0[r + 1]); b = A2_MX3(b, p0[r + 2], p0[r + 3]); a = A2_MX3(a, p1[r], p1[r + 1]); b = A2_MX3(b, p1[r + 2], p1[r + 3]); }
    const float m = __builtin_fmaxf(a, b); auto rr = __builtin_amdgcn_permlane32_swap(__float_as_uint(m), __float_as_uint(m), false, false);
    return __builtin_fmaxf(__uint_as_float(rr[0]), __uint_as_float(rr[1])); }
__device__ __forceinline__ float halfsum(float v) { auto rr = __builtin_amdgcn_permlane32_swap(__float_as_uint(v), __float_as_uint(v), false, false); return __uint_as_float(rr[0]) + __uint_as_float(rr[1]); }

struct Ctx {
    LAS unsigned char* lds;
    int wid, lane, r32, hi;
    int tq;
    int hg;
    bf16x8 qr[4];
    unsigned voffK, voffV;
};
__device__ __forceinline__ void glds16(unsigned voff, const void* sbase, unsigned lds_base) {
    unsigned sv; asm volatile("s_mov_b32 %0, m0\n\ts_mov_b32 m0, %3\n\ts_nop 0\n\tglobal_load_lds_dwordx4 %1, %2\n\ts_mov_b32 m0, %0" : "=&s"(sv) : "v"(voff), "s"(sbase), "s"(lds_base) : "memory"); }
__device__ __forceinline__ void stage(const Ctx& C, const bf16* ksrc, const bf16* vsrc, int slot) {
    const unsigned base = (unsigned)(uintptr_t)C.lds + (unsigned)(slot * SLOTB + C.wid * 1024);
    glds16(C.voffK, ksrc, (unsigned)__builtin_amdgcn_readfirstlane((int)(base + L_K)));
    glds16(C.voffV, vsrc, (unsigned)__builtin_amdgcn_readfirstlane((int)(base + L_V)));
}
struct Pipe {
    const bf16 *KV, *KC; int w;
    int k, pass, idx, n; const bf16 *kb, *vb;
    int issued, s;
    unsigned long long tacc;
    __device__ __forceinline__ int qt_of(int kk) const { const int r = w & 15; return kk == 0 ? r : (kk == 1 ? 31 - r : (kk == 2 ? 32 + r : 63 - r)); }
    __device__ __forceinline__ void setup_pass() {
        const int bg = w >> 4, qt = qt_of(k); const size_t kvslab = (size_t)bg * 4096 * 64, kvstride = (size_t)NB * 2 * 4096 * 64;
        if (pass < 2) { n = (4 * qt + 66) >> 6; kb = KC + (size_t)bg * 256 * 64; vb = kb + (size_t)16 * 256 * 64; }
        else if (pass == 2) { n = qt + 1; kb = KV + 2 * kvstride + kvslab; vb = kb + kvstride; }
        else { const int j0 = qt > 8 ? qt - 8 : 0; n = qt - j0 + 1; kb = KV + 4 * kvstride + kvslab + (size_t)j0 * 4096; vb = kb + kvstride; }
    }
    __device__ __forceinline__ void init(const bf16* KV_, const bf16* KC_, int w_) { KV = KV_; KC = KC_; w = w_; k = 0; pass = 0; idx = 0; issued = 0; s = 0; tacc = 0; setup_pass(); }
    __device__ __forceinline__ void issue_next(const Ctx& C) {
        if (k < 4) { stage(C, kb + (size_t)idx * 4096, vb + (size_t)idx * 4096, issued & (NSLOT - 1)); ++issued; ++idx;
            if (idx == n) { idx = 0; ++pass; if (pass == 4) { pass = 0; ++k; } if (k < 4) setup_pass(); } }
    }
    __device__ __forceinline__ void wait_bar(int pending) {
        { TSEC_BEGIN(8);
        if (pending >= 2) asm volatile("s_waitcnt vmcnt(4) lgkmcnt(0)" ::: "memory"); else if (pending == 1) asm volatile("s_waitcnt vmcnt(2) lgkmcnt(0)" ::: "memory"); else asm volatile("s_waitcnt vmcnt(0) lgkmcnt(0)" ::: "memory");
        TSEC_END(8, *this); }
        __builtin_amdgcn_s_barrier(); asm volatile("" ::: "memory");
    }
    __device__ __forceinline__ void prologue(const Ctx& C) { issue_next(C); issue_next(C); issue_next(C); wait_bar(issued - 1); }
    __device__ __forceinline__ int slot() const { return s & (NSLOT - 1); }
    __device__ __forceinline__ void begin_step(const Ctx& C) { issue_next(C); }
    __device__ __forceinline__ void end_step() { TSEC_BEGIN(1); wait_bar(issued - (s + 2)); TSEC_END(1, *this); ++s; }
};
__device__ __forceinline__ void scores(const Ctx& C, int slot, f32x16& s0, f32x16& s1) {
    const lds_cptr kp = (lds_cptr)C.lds + L_K + slot * SLOTB + C.hi * 1024 + C.r32 * 16;
    bf16x8 kf[8];
#pragma unroll
    for (int d0 = 0; d0 < 4; ++d0) { kf[2 * d0] = *(const LAS bf16x8*)(kp + d0 * 2048); kf[2 * d0 + 1] = *(const LAS bf16x8*)(kp + d0 * 2048 + 512); }
    f32x16 z;
#pragma unroll
    for (int i = 0; i < 16; ++i) z[i] = 0.f;
    s0 = A2_MFMA(kf[0], C.qr[0], z); s1 = A2_MFMA(kf[1], C.qr[0], z);
    s0 = A2_MFMA(kf[2], C.qr[1], s0); s1 = A2_MFMA(kf[3], C.qr[1], s1);
    s0 = A2_MFMA(kf[4], C.qr[2], s0); s1 = A2_MFMA(kf[5], C.qr[2], s1);
    s0 = A2_MFMA(kf[6], C.qr[3], s0); s1 = A2_MFMA(kf[7], C.qr[3], s1);
}
__device__ __forceinline__ void bias_far(f32x16& s0, f32x16& s1, float cl) {
#pragma unroll
    for (int r = 0; r < 16; ++r) { s0[r] += cl; s1[r] += cl; }
}
__device__ __forceinline__ void bias_near(const Ctx& C, f32x16& s0, f32x16& s1, int kbase, int kstep, int maxd, bool colsel) {
    const unsigned lutb = (unsigned)(uintptr_t)(C.lds + L_LUT) + (unsigned)C.hg * 4u;
    const int d0 = C.tq - kbase - kstep * 4 * C.hi;
#pragma unroll
    for (int half = 0; half < 2; ++half) {
        f32x16& sx = half ? s1 : s0; const int dh = d0 - half * 32 * kstep;
#pragma unroll
        for (int q4 = 0; q4 < 2; ++q4) {
            unsigned ad[8]; float bb[8];
#pragma unroll
            for (int i = 0; i < 8; ++i) { const int r = q4 * 8 + i; const int da = dh - kstep * ((r & 3) + 8 * (r >> 2)); const int ia = da < 0 ? 0 : (da > 127 ? 127 : da); ad[i] = lutb + (unsigned)ia * 32u; }
            asm volatile("ds_read_b32 %0, %8\n\tds_read_b32 %1, %9\n\tds_read_b32 %2, %10\n\tds_read_b32 %3, %11\n\tds_read_b32 %4, %12\n\tds_read_b32 %5, %13\n\tds_read_b32 %6, %14\n\tds_read_b32 %7, %15\n\ts_waitcnt lgkmcnt(0)"
                         : "=&v"(bb[0]), "=&v"(bb[1]), "=&v"(bb[2]), "=&v"(bb[3]), "=&v"(bb[4]), "=&v"(bb[5]), "=&v"(bb[6]), "=&v"(bb[7])
                         : "v"(ad[0]), "v"(ad[1]), "v"(ad[2]), "v"(ad[3]), "v"(ad[4]), "v"(ad[5]), "v"(ad[6]), "v"(ad[7]) : "memory");
#pragma unroll
            for (int i = 0; i < 8; ++i) { const int r = q4 * 8 + i; const int da = dh - kstep * ((r & 3) + 8 * (r >> 2)); const bool ok = colsel && da >= 0 && da <= maxd; const float v = sx[r] + bb[i]; sx[r] = ok ? v : MASKED; }
        }
    }
}
struct Acc { f32x16 o[2]; float m, l; };
__device__ __forceinline__ void acc_zero(Acc& a, float m0) {
#pragma unroll
    for (int i = 0; i < 16; ++i) { a.o[0][i] = 0.f; a.o[1][i] = 0.f; }
    a.m = m0; a.l = 0.f;
}
__device__ __forceinline__ void pv(const Ctx& C, int slot, const f32x16& p0, const f32x16& p1, f32x16 (&o)[2], bool colsel = true) {
    v4u pw[4];
#pragma unroll
    for (int k = 0; k < 2; ++k) { pw[k] = (v4u){pk2(p0[8 * k], p0[8 * k + 1]), pk2(p0[8 * k + 2], p0[8 * k + 3]), pk2(p0[8 * k + 4], p0[8 * k + 5]), pk2(p0[8 * k + 6], p0[8 * k + 7])};
                                  pw[2 + k] = (v4u){pk2(p1[8 * k], p1[8 * k + 1]), pk2(p1[8 * k + 2], p1[8 * k + 3]), pk2(p1[8 * k + 4], p1[8 * k + 5]), pk2(p1[8 * k + 6], p1[8 * k + 7])}; }
    if (!__all(colsel)) {
#pragma unroll
        for (int k = 0; k < 4; ++k) { pw[k].x = colsel ? pw[k].x : 0u; pw[k].y = colsel ? pw[k].y : 0u; pw[k].z = colsel ? pw[k].z : 0u; pw[k].w = colsel ? pw[k].w : 0u; } }
    const lds_cptr vp = (lds_cptr)C.lds + L_V + slot * SLOTB + ((C.lane >> 4) & 1) * 32 + (C.lane & 3) * 8 + (4 * C.hi + ((C.lane & 15) >> 2)) * 64;
#pragma unroll
    for (int dh = 0; dh < 2; ++dh) {
        s16x4 vlo[4], vhi[4];
#pragma unroll
        for (int k = 0; k < 4; ++k) { vlo[k] = vtr(vp + dh * 4096 + k * 1024); vhi[k] = vtr(vp + dh * 4096 + k * 1024 + 512); }
#pragma unroll
        for (int k = 0; k < 4; ++k) { const bf16x8 vf = (bf16x8){vlo[k][0], vlo[k][1], vlo[k][2], vlo[k][3], vhi[k][0], vhi[k][1], vhi[k][2], vhi[k][3]};
            o[dh] = A2_MFMA(__builtin_bit_cast(bf16x8, pw[k]), vf, o[dh]); }
    }
}
__device__ __forceinline__ void softmax_step(const Ctx& C, Acc& a, f32x16& s0, f32x16& s1, float cl, bool colsel) {
    LAS float* wsf = (LAS float*)(C.lds + L_WS + C.wid * WS_PER_WAVE + W_WSF);
    const float mt = colsel ? rowmax(s0, s1) + cl : -3.0e38f;
    if (__any(mt - a.m > THR)) {
        const float mn = __builtin_fmaxf(a.m, mt), f = __builtin_amdgcn_exp2f(a.m - mn);
        a.l *= f; a.m = mn;
        if (C.hi == 0) wsf[C.r32] = f;
        asm volatile("s_waitcnt lgkmcnt(0)" ::: "memory");
#pragma unroll
        for (int r = 0; r < 16; ++r) { const float fr = wsf[crow(r, C.hi)]; a.o[0][r] *= fr; a.o[1][r] *= fr; }
        asm volatile("s_waitcnt lgkmcnt(0)" ::: "memory");
    }
    const float nm = cl - a.m; float sacc = 0.f;
    if (__all(nm == 0.f)) {
#pragma unroll
        for (int r = 0; r < 16; ++r) { s0[r] = __builtin_amdgcn_exp2f(s0[r]); s1[r] = __builtin_amdgcn_exp2f(s1[r]); sacc += s0[r] + s1[r]; }
    } else {
#pragma unroll
        for (int r = 0; r < 16; ++r) { s0[r] = __builtin_amdgcn_exp2f(s0[r] + nm); s1[r] = __builtin_amdgcn_exp2f(s1[r] + nm); sacc += s0[r] + s1[r]; }
    }
    a.l += colsel ? sacc : 0.f;
}
__device__ __forceinline__ void fold(const Ctx& C, const Acc& a, int branch, unsigned (&outp)[16]) {
    LAS float* tbl = (LAS float*)(C.lds + L_WS + C.wid * WS_PER_WAVE + W_TBL);
    const LAS float* gate = (const LAS float*)(C.lds + L_WS + C.wid * WS_PER_WAVE + W_GATE);
    const float l = halfsum(a.l);
    if (C.hi == 0) tbl[C.r32] = (l > 0.f ? __builtin_amdgcn_rcpf(l) : 0.f) * gate[C.r32 * 4 + branch];
    asm volatile("s_waitcnt lgkmcnt(0)" ::: "memory");
#pragma unroll
    for (int r = 0; r < 16; ++r) { const float f = tbl[crow(r, C.hi)]; outp[r] = pk2(bflo(outp[r]) + f * a.o[0][r], bfhi(outp[r]) + f * a.o[1][r]); }
    asm volatile("s_waitcnt lgkmcnt(0)" ::: "memory");
}

__device__ __forceinline__ void unit(Ctx& C, Pipe& P, int b, int g, int qt, const bf16* Q, const bf16* GT, bf16* O) {
    LAS unsigned char* lds = C.lds; const int wid = C.wid, lane = C.lane;
    const int t0 = qt * 64, ql = C.r32 >> 2, hl = C.r32 & 3;
    C.tq = t0 + 8 * wid + ql; C.hg = g * 4 + hl;
    const size_t row = (size_t)b * 4096 + C.tq;
    LAS unsigned char* wsb = lds + L_WS + wid * WS_PER_WAVE;
#pragma unroll
    for (int d0 = 0; d0 < 4; ++d0) C.qr[d0] = *(const bf16x8*)(Q + row * 512 + C.hg * 64 + d0 * 16 + C.hi * 8);
    if (C.hi == 0) { LAS float* gate = (LAS float*)(wsb + W_GATE);
#pragma unroll
        for (int br = 0; br < 3; ++br) gate[C.r32 * 4 + br] = bf2f(GT[row * 32 + C.hg * 3 + br]); }
    { LAS float* imp = (LAS float*)(wsb + W_IMP);
#pragma unroll
        for (int i = 0; i < 8; ++i) imp[lane + 64 * i] = 0.f; }
    const float lut31 = ((const LAS float*)(lds + L_LUT))[127 * 8 + C.hg];
    unsigned out[16];
#pragma unroll
    for (int i = 0; i < 16; ++i) out[i] = 0u;
    Acc a; f32x16 s0, s1;
    const int tmax = t0 + 63, nvis_max = tmax >= 31 ? ((tmax - 31) >> 4) + 1 : 0, ntc = (nvis_max + 63) >> 6;
    const int twmin = t0 + 8 * wid;
    float mc = MINIT, lc = 0.f;
#pragma unroll 1
    for (int tl = 0; tl < ntc; ++tl) {
        P.begin_step(C);
        scores(C, P.slot(), s0, s1);
        float cl = 0.f;
        if (twmin - (16 * (64 * tl + 63) + 31) >= 113) cl = lut31; else bias_near(C, s0, s1, 16 * 64 * tl + 31, 16, 1 << 30, true);
        const float mt = rowmax(s0, s1) + cl, mn = __builtin_fmaxf(mc, mt); float sacc = 0.f; const float nm = cl - mn;
#pragma unroll
        for (int r = 0; r < 16; ++r) sacc += __builtin_amdgcn_exp2f(s0[r] + nm) + __builtin_amdgcn_exp2f(s1[r] + nm);
        lc = lc * __builtin_amdgcn_exp2f(mc - mn) + sacc; mc = mn;
        P.end_step();
    }
    { const float lf = halfsum(lc); lc = lf > 0.f ? __builtin_amdgcn_rcpf(lf) : 0.f; }
    acc_zero(a, 0.f);
#pragma unroll 1
    for (int tl = 0; tl < ntc; ++tl) {
        P.begin_step(C);
        scores(C, P.slot(), s0, s1);
        float cl = 0.f;
        if (twmin - (16 * (64 * tl + 63) + 31) >= 113) cl = lut31; else bias_near(C, s0, s1, 16 * 64 * tl + 31, 16, 1 << 30, true);
        const float nm = cl - mc;
#pragma unroll
        for (int r = 0; r < 16; ++r) { s0[r] = __builtin_amdgcn_exp2f(s0[r] + nm) * lc; s1[r] = __builtin_amdgcn_exp2f(s1[r] + nm) * lc; }
        {
            LAS float* imp = (LAS float*)(wsb + W_IMP) + ql * 64;
#pragma unroll
            for (int aa = 0; aa < 4; ++aa) {
                const int nb0 = 16 * tl + 2 * aa + C.hi, nb1 = nb0 + 8;
                const float g0 = (s0[4 * aa] + s0[4 * aa + 1]) + (s0[4 * aa + 2] + s0[4 * aa + 3]), g1 = (s1[4 * aa] + s1[4 * aa + 1]) + (s1[4 * aa + 2] + s1[4 * aa + 3]);
                (void)__hip_atomic_fetch_add(imp + nb0, g0, __ATOMIC_RELAXED, __HIP_MEMORY_SCOPE_WORKGROUP);
                (void)__hip_atomic_fetch_add(imp + nb1, g1, __ATOMIC_RELAXED, __HIP_MEMORY_SCOPE_WORKGROUP);
                if (nb0 + 1 < 64) (void)__hip_atomic_fetch_add(imp + nb0 + 1, s0[4 * aa + 3], __ATOMIC_RELAXED, __HIP_MEMORY_SCOPE_WORKGROUP);
                if (nb1 + 1 < 64) (void)__hip_atomic_fetch_add(imp + nb1 + 1, s1[4 * aa + 3], __ATOMIC_RELAXED, __HIP_MEMORY_SCOPE_WORKGROUP);
            }
        }
        pv(C, P.slot(), s0, s1, a.o);
        P.end_step();
    }
    a.l = 0.5f;
    fold(C, a, 0, out);
    unsigned long long mymask = 0ull, anymask = 0ull;
    { TSEC_BEGIN(6);
        const LAS float* imp = (const LAS float*)(wsb + W_IMP);
        const int n = lane; const bool forced = (n == 0) || (n == qt) || (n == qt - 1), val = n <= qt;
#pragma unroll 1
        for (int q8 = 0; q8 < 8; ++q8) {
            const float score = forced ? 1e9f : (val ? imp[q8 * 64 + n] : -1e9f);
            const unsigned u = __float_as_uint(score), key = (u & 0x80000000u) ? ~u : (u | 0x80000000u);
            unsigned T = 0u;
#pragma unroll
            for (int bit = 31; bit >= 0; --bit) { const unsigned cand = T | (1u << bit); if (__builtin_popcountll(__ballot(key >= cand)) >= 16) T = cand; }
            unsigned long long gt = __ballot(key > T), eq = __ballot(key == T);
            int need = 16 - __builtin_popcountll(gt);
            while (need > 0 && eq) { const unsigned long long low = eq & (0ull - eq); gt |= low; eq ^= low; --need; }
            const unsigned long long sel = gt & __ballot(val);
            anymask |= sel; if (ql == q8) mymask = sel;
        }
      TSEC_END(6, P); }
#pragma unroll 1
    for (int ph = 0; ph < 2; ++ph) {
        acc_zero(a, lut31);
        const int j0 = ph ? (qt > 8 ? qt - 8 : 0) : 0, nj = qt - j0 + 1, maxd = ph ? 511 : (1 << 30);
#pragma unroll 1
        for (int i = 0; i < nj; ++i) {
            const int j = j0 + i;
            P.begin_step(C);
            const bool wave_on = ph ? true : ((anymask >> j) & 1ull) != 0ull;
            if (wave_on) {
                const bool colsel = ph ? true : ((mymask >> j) & 1ull) != 0ull;
                scores(C, P.slot(), s0, s1);
                const bool far = (j <= qt - 3) && !(ph && j == qt - 8);
                float cl = 0.f; bool cs = true;
                if (far) { cl = lut31; cs = colsel; } else bias_near(C, s0, s1, 64 * j, 1, maxd, colsel);
                softmax_step(C, a, s0, s1, cl, cs);
                pv(C, P.slot(), s0, s1, a.o, cs);
            }
            P.end_step();
        }
        fold(C, a, 1 + ph, out);
    }
    {
        bf16* stg = (bf16*)(wsb + W_OST);
#pragma unroll
        for (int r = 0; r < 16; ++r) { const int c = crow(r, C.hi);
            stg[c * 64 + C.r32] = (bf16)(out[r] & 0xffffu); stg[c * 64 + 32 + C.r32] = (bf16)(out[r] >> 16); }
        asm volatile("s_waitcnt lgkmcnt(0)" ::: "memory");
#pragma unroll
        for (int i = 0; i < 4; ++i) { const int c = i * 8 + (lane >> 3), ch = lane & 7;
            const v4u v = *(const LAS v4u*)(stg + c * 64 + ch * 8);
            *(v4u*)(O + ((size_t)b * 4096 + t0 + 8 * wid + (c >> 2)) * 512 + (g * 4 + (c & 3)) * 64 + ch * 8) = v; }
        asm volatile("s_waitcnt lgkmcnt(0)" ::: "memory");
    }
}
}

__device__ __forceinline__ void p4_attention(Frame& F, const Args& A) {
    unsigned char* ws = F.ws;
    LAS unsigned char* lds = F.lds + RING_OFF;
    { LAS float* lut = (LAS float*)(lds + att2::L_LUT); for (int e = F.tid; e < 1024; e += 512) lut[e] = ((const float*)(ws + WS_SMALL + SM_LUT))[e] * 1.4426950408889634f; }
    __syncthreads();
    const bf16* Q = (const bf16*)(ws + WS_Q); const bf16* KV = (const bf16*)(ws + WS_KV); const bf16* KC = (const bf16*)(ws + WS_KC); const bf16* GT = (const bf16*)(ws + WS_G);
    bf16* O = (bf16*)(ws + WS_O);
#ifndef PROBE_ATTN_REPS
#define PROBE_ATTN_REPS 1
#endif
    for (int ww = F.vcu; ww < 256 * PROBE_ATTN_REPS; ww += F.G) {
        const int w = ww & 255; const int bg = w >> 4, b = bg >> 1, g = bg & 1;
        att2::Ctx C; C.lds = lds; C.wid = F.wave; C.lane = F.lane; C.r32 = F.lane & 31; C.hi = F.lane >> 5;
        C.voffK = (unsigned)(C.lane * 64 + C.wid * 8) * 2u; C.voffV = (unsigned)((16 * (C.wid & 3) + (C.lane >> 2)) * 64 + (C.wid >> 2) * 32 + (C.lane & 3) * 8) * 2u;
        att2::Pipe P; P.init(KV, KC, w); P.prologue(C);
#pragma unroll 1
        for (int k = 0; k < 4; ++k) att2::unit(C, P, b, g, P.qt_of(k), Q, GT, O);
        asm volatile("s_waitcnt vmcnt(0) lgkmcnt(0)" ::: "memory"); __builtin_amdgcn_s_barrier(); asm volatile("" ::: "memory");
        if (PROBE_SECTION != 0 && F.wave == 0) { const unsigned long long t0 = __builtin_amdgcn_s_memtime(); while (__builtin_amdgcn_s_memtime() - t0 < P.tacc) __builtin_amdgcn_s_sleep(4); }
        if (PROBE_SECTION != 0) __builtin_amdgcn_s_barrier();
    }
}

__device__ __forceinline__ void p8_ln(Frame& F, const Args& A) {
    unsigned char* ws = F.ws; const int lane = F.lane;
    float* H1 = (float*)(ws + WS_H1); bf16* H1B = (bf16*)(ws + WS_H1B); bf16* HLO = (bf16*)(ws + WS_HLO);
    const int gw = F.vcu * NWAVES + F.wave, NGW = F.G * NWAVES;
    f32x4 gam[4], bet[4];
#pragma unroll
    for (int j = 0; j < 4; ++j) { gam[j] = ((const f32x4*)A.in[I_LN1G])[lane + 64 * j]; bet[j] = ((const f32x4*)A.in[I_LN1B])[lane + 64 * j]; }
#pragma unroll 2
    for (int m = gw; m < NTOK; m += NGW) {
        f32x4* xr = (f32x4*)(H1 + (size_t)m * DM) + lane; f32x4 h[4]; float s = 0.f;
#pragma unroll
        for (int j = 0; j < 4; ++j) { h[j] = xr[64 * j]; s += (h[j].x + h[j].y) + (h[j].z + h[j].w); }
        const float mean = wave_sum(s) * (1.f / DM); float s2 = 0.f;
#pragma unroll
        for (int j = 0; j < 4; ++j) { h[j] = h[j] - mean; s2 += (h[j].x * h[j].x + h[j].y * h[j].y) + (h[j].z * h[j].z + h[j].w * h[j].w); }
        const float rstd = 1.0f / sqrtf(wave_sum(s2) * (1.f / DM) + LN_EPS);
        v2u* o8 = (v2u*)(H1B + (size_t)m * DM) + lane; v2u* l8 = (v2u*)(HLO + (size_t)m * DM) + lane;
#pragma unroll
        for (int j = 0; j < 4; ++j) { h[j] = h[j] * rstd * gam[j] + bet[j]; xr[64 * j] = h[j];
            v2u w; w.x = pk2(h[j].x, h[j].y); w.y = pk2(h[j].z, h[j].w); o8[64 * j] = w;
            v2u q; q.x = pk2(h[j].x - bflo(w.x), h[j].y - bfhi(w.x)); q.y = pk2(h[j].z - bflo(w.y), h[j].w - bfhi(w.y)); l8[64 * j] = q; }
    }
}
template <class P> __device__ __forceinline__ int moe_tables(Frame& F, P cnt, LAS int* pstart  , LAS unsigned char* tile_e  ) {
    LAS int* nt = (LAS int*)(pstart + 64);
    if (F.tid == 0) { int acc = 0;
        for (int e = 0; e < 64; ++e) { const int c = (int)cnt[e]; const int tiles = (c + 255) >> 8; pstart[e] = acc * 256;
            for (int k = 0; k < tiles; ++k) tile_e[acc + k] = (unsigned char)e; acc += tiles; }
        nt[0] = acc; }
    __syncthreads();
    return nt[0];
}
__device__ __forceinline__ void p9_scatter(Frame& F, const Args& A) {
    unsigned char* ws = F.ws; const int lane = F.lane;
    LAS int* pstart = (LAS int*)(F.lds + LTAB_OFF); LAS unsigned char* tile_e = (LAS unsigned char*)(F.lds + LTAB_OFF + 512);
    LAS int* pre = (LAS int*)(F.lds + RING_OFF);
    LAS int* tot = pre + 128 * 64;
    const int* HIST = (const int*)(ws + WS_HIST);
    if (F.tid < 64) { int acc = 0;
#pragma unroll 8
        for (int w = 0; w < 128; ++w) { pre[w * 64 + F.tid] = acc; acc += HIST[w * 64 + F.tid]; }
        tot[F.tid] = acc; if (F.vcu == 0) ((int*)F.ctl)[CW_CNT + F.tid] = acc; }
    __syncthreads();
    (void)moe_tables(F, tot, pstart, tile_e);
    const bf16* H1B = (const bf16*)(ws + WS_H1B); bf16* XS = (bf16*)(ws + WS_XS); int* ROUTE = (int*)(ws + WS_ROUTE);
    const int gw = F.vcu * NWAVES + F.wave, NGW = F.G * NWAVES;
#pragma unroll 1
    for (int t0 = gw * 16; t0 < NTOK; t0 += NGW * 16) {
        int p1 = 0, p2 = 0;
        if (lane < 16) { int* rt = ROUTE + (size_t)(t0 + lane) * 8; const int e1 = rt[0], e2 = rt[1], w = (t0 + lane) >> 8;
            p1 = pstart[e1] + pre[w * 64 + e1] + rt[4]; p2 = pstart[e2] + pre[w * 64 + e2] + rt[5]; rt[6] = p1; rt[7] = p2; }
#pragma unroll 4
        for (int k = 0; k < 16; ++k) {
            const int q1 = __shfl(p1, k), q2 = __shfl(p2, k);
            const v4u* src = (const v4u*)(H1B + (size_t)(t0 + k) * DM) + lane; const v4u a = src[0], b = src[64];
            v4u* d1 = (v4u*)(XS + (size_t)q1 * DM) + lane; v4u* d2 = (v4u*)(XS + (size_t)q2 * DM) + lane;
            d1[0] = a; d1[64] = b; d2[0] = a; d2[64] = b;
        }
    }
}
__device__ __forceinline__ void p12_final(Frame& F, const Args& A, float* out) {
    unsigned char* ws = F.ws; const int lane = F.lane;
    const float* H1 = (const float*)(ws + WS_H1); const bf16* Y2 = (const bf16*)(ws + WS_Y2); const int* ROUTE = (const int*)(ws + WS_ROUTE);
    const int gw = F.vcu * NWAVES + F.wave, NGW = F.G * NWAVES;
    f32x4 gam[4], bet[4];
#pragma unroll
    for (int j = 0; j < 4; ++j) { gam[j] = ((const f32x4*)A.in[I_LN2G])[lane + 64 * j]; bet[j] = ((const f32x4*)A.in[I_LN2B])[lane + 64 * j]; }
    for (int m = gw; m < NTOK; m += NGW) {
        const int* rt = ROUTE + (size_t)m * 8; const float w1 = __int_as_float(rt[2]), w2 = __int_as_float(rt[3]); const int p1 = rt[6], p2 = rt[7];
        const f32x4* xr = (const f32x4*)(H1 + (size_t)m * DM) + lane; const v2u* y1 = (const v2u*)(Y2 + (size_t)p1 * DM) + lane; const v2u* y2 = (const v2u*)(Y2 + (size_t)p2 * DM) + lane;
        f32x4 v[4]; float s = 0.f;
#pragma unroll
        for (int j = 0; j < 4; ++j) { const f32x4 x = xr[64 * j]; const v2u a = y1[64 * j], b = y2[64 * j];
            v[j].x = x.x * DN_ALPHA + (w1 * bflo(a.x) + w2 * bflo(b.x)); v[j].y = x.y * DN_ALPHA + (w1 * bfhi(a.x) + w2 * bfhi(b.x));
            v[j].z = x.z * DN_ALPHA + (w1 * bflo(a.y) + w2 * bflo(b.y)); v[j].w = x.w * DN_ALPHA + (w1 * bfhi(a.y) + w2 * bfhi(b.y));
            s += (v[j].x + v[j].y) + (v[j].z + v[j].w); }
        const float mean = wave_sum(s) * (1.f / DM); float s2 = 0.f;
#pragma unroll
        for (int j = 0; j < 4; ++j) { v[j] = v[j] - mean; s2 += (v[j].x * v[j].x + v[j].y * v[j].y) + (v[j].z * v[j].z + v[j].w * v[j].w); }
        const float rstd = 1.0f / sqrtf(wave_sum(s2) * (1.f / DM) + LN_EPS);
        f32x4* o = (f32x4*)(out + (size_t)m * DM) + lane;
#pragma unroll
        for (int j = 0; j < 4; ++j) o[64 * j] = v[j] * rstd * gam[j] + bet[j];
    }
}

__global__ void __launch_bounds__(NWAVES * 64, 2) fwd(Args args) {
    extern __shared__ __attribute__((aligned(16))) unsigned char lds[];
    Frame F;
    F.lds = (LAS unsigned char*)lds;
    F.MISC = (volatile LAS unsigned*)(F.lds + MISC_OFF);
    F.tid = threadIdx.x; F.lane = F.tid & 63; F.wave = __builtin_amdgcn_readfirstlane(F.tid >> 6);
    F.G = gridDim.x; { const int bx = blockIdx.x; F.vcu = (F.G % 8 == 0) ? (bx % 8) * (F.G / 8) + bx / 8 : bx; }
    F.ws = args.ws; F.ctl = (gu32*)(args.ws + WS_CTL); F.in = nullptr;
    unsigned char* ws = args.ws;
    for (int u = F.tid; u < (LDS_BYTES - LDSCTL_OFF) / 4; u += NWAVES * 64) ((LAS unsigned*)(F.lds + LDSCTL_OFF))[u] = 0u;
    __syncthreads();
    XcdBarrier bar; bar.bar = (unsigned*)(F.ctl + CW_BAR); bar.x = 0; bar.st = nullptr;
    if (MK_N_LAUNCHES == 1) bar = xcd_barrier_post((unsigned*)(F.ctl + CW_BAR), F.MISC + 8);
#define GRID_BAR() do { if (MK_N_LAUNCHES == 1) xcd_barrier(bar); } while (0)
    const int lo = args.ph_lo, hi = args.ph_hi;
#ifndef PH_MASK
#define PH_MASK 0x1fff
#endif
#define IN(k) ((((PH_MASK) >> (k)) & 1) && lo <= (k) && (k) < hi)
#define BOTH(k) (IN(k) && IN((k) + 1))
#ifndef PROBE_REP_MASK
#define PROBE_REP_MASK 0
#endif
#define REPS(k) for (int rep_ = 0; rep_ < 1 + (((PROBE_REP_MASK) >> (k)) & 1); ++rep_)
    LAS unsigned char* ring = F.lds + RING_OFF;

    if (IN(0)) { _Pragma("unroll") REPS(0) { p0_prologue(F, args); __syncthreads(); } if (BOTH(0)) GRID_BAR(); }
    if (IN(1)) {
        pg8::Gemm g{(const bf16*)(ws + WS_XB), (const bf16*)(ws + WS_WINT), 1024, 1024, 1024}; pg8::StaticOrder S; S.init(NTOK, NPROJ, F.G, (int)blockIdx.x);
        EpiProj E{(bf16*)(ws + WS_Q), (bf16*)(ws + WS_KV), (bf16*)(ws + WS_SA), (bf16*)(ws + WS_MG), (bf16*)(ws + WS_G), (const float*)(ws + WS_SMALL + SM_BIASR)};
        _Pragma("unroll") REPS(1) { pg8::gemm_phase<EpiProj, pg8::StaticOrder, true, true>(ring, g, S, E); }
        if (BOTH(1)) GRID_BAR();
    }
    if (IN(2)) {
        REPS(2) {
        if (F.vcu < 32) { pg8::Gemm g{(const bf16*)(ws + WS_KV), (const bf16*)(ws + WS_W1CT), 1024, 2048, 2048}; ListOrder S{32, F.G, F.vcu, 1, 16};
          EpiF32Half<true> E{(float*)(ws + WS_HID), (const float*)(ws + WS_SMALL + SM_B1C)};
          pg8::gemm_phase<EpiF32Half<true>, ListOrder, true, true>(ring, g, S, E); }
        else expert_transposes(F, args, 32);
        { pg8::Gemm g{(const bf16*)(ws + WS_SA) + 128, (const bf16*)(ws + WS_BPT), 384, 256, 256}; ListOrder S{256, F.G, F.vcu, 1, 8};
          EpiF32Half<false> E{(float*)(ws + WS_E), nullptr};
          pg8::gemm_phase<EpiF32Half<false>, ListOrder, true, true>(ring, g, S, E); }
        }
        if (BOTH(2)) GRID_BAR();
    }
    if (IN(3)) { _Pragma("unroll") REPS(3) { p3_thin(F, args); } if (BOTH(3)) GRID_BAR(); }
    if (IN(4)) {
        REPS(4) {
        { int k384 = 384; asm volatile("" : "+s"(k384));
          pg8::Gemm g{(const bf16*)(ws + WS_SA), (const bf16*)(ws + WS_CT), 384, 384, k384}; ListOrder S{256, F.G, F.vcu, 1, 8};
          EpiS5Y E{(bf16*)(ws + WS_Z)};
          pg8::gemm_phase<EpiS5Y, ListOrder, true, true>(ring, g, S, E); }
        __syncthreads();
        p4_attention(F, args);
        __syncthreads(); }
        if (BOTH(4)) GRID_BAR();
    }
    if (IN(5)) {
        pg8::Gemm g{(const bf16*)(ws + WS_O), (const bf16*)(ws + WS_WAT), 512, 512, 512}; pg8::StaticOrder S; S.init(NTOK, 1024, F.G, (int)blockIdx.x);
        EpiYa E{(bf16*)(ws + WS_T), (const bf16*)(ws + WS_MG)};
        _Pragma("unroll") REPS(5) { pg8::gemm_phase<EpiYa, pg8::StaticOrder, true, true>(ring, g, S, E); }
        if (BOTH(5)) GRID_BAR();
    }
    if (IN(6)) {
        pg8::Gemm g{(const bf16*)(ws + WS_Z), (const bf16*)(ws + WS_WVGT), 512, 512, 512}; pg8::StaticOrder S; S.init(NTOK, 2048, F.G, (int)blockIdx.x);
        EpiYb E{(const bf16*)(ws + WS_T), (const bf16*)(ws + WS_MG), args.in[I_BGATE], (bf16*)(ws + WS_MIX)};
        REPS(6) { pg8::gemm_phase<EpiYb, pg8::StaticOrder, true, true>(ring, g, S, E); }
        if (BOTH(6)) GRID_BAR();
    }
    if (IN(7)) {
        pg8::Gemm g{(const bf16*)(ws + WS_MIX), (const bf16*)(ws + WS_WOT), 1024, 1024, 1024}; pg8::StaticOrder S; S.init(NTOK, 1024, F.G, (int)blockIdx.x);
        EpiOut E{args.in[I_X], (float*)(ws + WS_H1)};
        _Pragma("unroll") REPS(7) { pg8::gemm_phase<EpiOut, pg8::StaticOrder, true, true>(ring, g, S, E); }
        if (BOTH(7)) GRID_BAR();
    }
    if (IN(8)) {
        p8_ln(F, args);
        GRID_BAR();
        { pg8::Gemm g{(const bf16*)(ws + WS_H1B), (const bf16*)(ws + WS_WRT), 1024, 1024, 1024}; RouterOrder S{F.vcu};
          EpiRouter E{args.in[I_RBG], args.in[I_RBE], (int*)(ws + WS_ROUTE), (int*)(ws + WS_HIST)};
          REPS(8) { pg8::gemm_phase<EpiRouter, RouterOrder, false, true, true>(ring, g, S, E); } }
        if (BOTH(8)) GRID_BAR();
    }
    if (IN(9)) { REPS(9) { p9_scatter(F, args); __syncthreads(); } if (BOTH(9)) GRID_BAR(); }
    if (IN(10)) {
        LAS int* pstart = (LAS int*)(F.lds + LTAB_OFF); LAS unsigned char* tile_e = (LAS unsigned char*)(F.lds + LTAB_OFF + 512);
        const int ntiles = moe_tables(F, (const int*)F.ctl + CW_CNT, pstart, tile_e);
        pg8::Gemm g{(const bf16*)(ws + WS_XS), (const bf16*)(ws + WS_WGUT), 1024, 1024, 1024}; MoeOrder S{ntiles * 2, F.G, F.vcu, 2, tile_e};
        EpiMoe1 E{(bf16*)(ws + WS_HB)};
        _Pragma("unroll") REPS(10) { pg8::gemm_phase<EpiMoe1, MoeOrder, true, true>(ring, g, S, E); }
        if (BOTH(10)) GRID_BAR();
    }
    if (IN(11)) {
        LAS int* pstart = (LAS int*)(F.lds + LTAB_OFF); LAS unsigned char* tile_e = (LAS unsigned char*)(F.lds + LTAB_OFF + 512);
        const int ntiles = moe_tables(F, (const int*)F.ctl + CW_CNT, pstart, tile_e);
        int k256 = 256; asm volatile("" : "+s"(k256));
        pg8::Gemm g{(const bf16*)(ws + WS_HB), (const bf16*)(ws + WS_WDT), 256, 256, k256}; MoeOrder S{ntiles * 4, F.G, F.vcu, 4, tile_e};
        EpiMoe2 E{(bf16*)(ws + WS_Y2)};
        _Pragma("unroll") REPS(11) { pg8::gemm_phase<EpiMoe2, MoeOrder, true, true>(ring, g, S, E); }
        if (BOTH(11)) GRID_BAR();
    }
#ifdef PROBE_EXTRA_BARS
    if (IN(12)) { _Pragma("unroll 1") for (int xb = 0; xb < PROBE_EXTRA_BARS; ++xb) GRID_BAR(); }
#endif
    if (IN(12)) { _Pragma("unroll") REPS(12) { p12_final(F, args, args.out); } }
#undef IN
#undef BOTH
}

extern "C" void kernel_launch(void* const* d_in, const int* in_sizes, int n_in, void* d_out, int out_size, void* d_ws, size_t ws_size, hipStream_t stream) {
    static int grid = 0;
    if (grid == 0) {
        if (n_in != 33 || out_size != NTOK * DM || ws_size < WS_END) { fprintf(stderr, "kernel_launch: unexpected problem shape (n_in %d, out %d, ws %zu)\n", n_in, out_size, ws_size); grid = -1; return; }
        int dev = 0, cus = 0, per_cu = 0;
        if (hipGetDevice(&dev) != hipSuccess || hipDeviceGetAttribute(&cus, hipDeviceAttributeMultiprocessorCount, dev) != hipSuccess) { grid = -1; return; }
        if (hipFuncSetAttribute((const void*)fwd, hipFuncAttributeMaxDynamicSharedMemorySize, LDS_BYTES) != hipSuccess) { fprintf(stderr, "kernel_launch: hipFuncSetAttribute failed\n"); grid = -1; return; }
        if (hipOccupancyMaxActiveBlocksPerMultiprocessor(&per_cu, (const void*)fwd, NWAVES * 64, LDS_BYTES) != hipSuccess || per_cu < 1)
            fprintf(stderr, "kernel_launch: occupancy query reports %d workgroups per CU\n", per_cu);
        (void)hipGetLastError();
        grid = cus;
    }
    if (grid < 0) return;
    if (hipMemsetAsync((char*)d_ws + WS_CTL, 0, CTL_ZERO_BYTES, stream) != hipSuccess) return;
    Args a{};
    for (int i = 0; i < 33; ++i) a.in[i] = (const float*)d_in[i];
    a.out = (float*)d_out; a.ws = (unsigned char*)d_ws;
    if (MK_N_LAUNCHES == 1) { a.ph_lo = 0; a.ph_hi = N_PHASES; hipLaunchKernelGGL(fwd, dim3(grid), dim3(NWAVES * 64), LDS_BYTES, stream, a); }
    else for (int li = 0; li < N_PHASES; ++li) { a.ph_lo = li; a.ph_hi = li + 1; hipLaunchKernelGGL(fwd, dim3(grid), dim3(NWAVES * 64), LDS_BYTES, stream, a); }
}
```
